# Optimizing an MI355X kernel written in HIP

```python
import math
import jax, jax.numpy as jnp
from jax import lax
import numpy as np


D_MODEL = 1024
BATCH = 4
SEQ = 8192
DEPTH = 2

GRID_W = 64
CTX_LEN = 256
MIX_W = D_MODEL
DA_HEAD_DIM = 64
DA_W = MIX_W // 2
DA_HEADS = DA_W // (2 * DA_HEAD_DIM)
FN_W = MIX_W - DA_W
FN_GROUPS = 4
FN_GW = FN_W // FN_GROUPS
Q_BLOCK = 128
ROPE_THETA = 10000.0
ROPE_AXIS_DIM = DA_HEAD_DIM // 2
HY_FILTER_EMB = 33
HY_FILTER_HIDDEN = 64
HY_DECAY_TARGET = 1e-2
HY_FAST_DECAY = 0.3
HY_SLOW_DECAY = 1.5
FFN_HIDDEN = ((8 * D_MODEL // 3 + 127) // 128) * 128
N_MOD = 6
LN_EPS = 1e-5
F32 = jnp.float32

kernel_name = 'hybrid_diffattn_fnet_hyena_convffn_dit'


def layer_norm(x, g=None, b=None):
    xf = x.astype(F32)
    mu = jnp.mean(xf, -1, keepdims=True)
    var = jnp.mean(jnp.square(xf - mu), -1, keepdims=True)
    y = (xf - mu) * lax.rsqrt(var + LN_EPS)
    if g is not None:
        y = y * g.astype(F32) + b.astype(F32)
    return y.astype(x.dtype)


def ada_params(cvec, w, b):
    m = jax.nn.silu(cvec) @ w + b
    return jnp.split(m[..., None, :], N_MOD, axis=-1)


def modulate(x, shift, scale):
    return layer_norm(x) * (1 + scale) + shift


def dwconv3(u, w, b):
    up = jnp.pad(u, ((0, 0), (1, 1), (0, 0)))
    return up[:, :-2] * w[0] + up[:, 1:-1] * w[1] + up[:, 2:] * w[2] + b


def axial_rope_angles(rows):
    pos_r = jnp.repeat(jnp.arange(rows, dtype=F32), GRID_W)
    pos_c = jnp.tile(jnp.arange(GRID_W, dtype=F32), rows)
    inv = ROPE_THETA ** (-jnp.arange(0, ROPE_AXIS_DIM, 2, dtype=F32) / ROPE_AXIS_DIM)
    return jnp.concatenate([pos_r[:, None] * inv, pos_c[:, None] * inv], -1)


def _rotate(xs, ang):
    x1, x2 = jnp.split(xs, 2, axis=-1)
    cos = jnp.cos(ang)[None, :, None, :].astype(xs.dtype)
    sin = jnp.sin(ang)[None, :, None, :].astype(xs.dtype)
    return jnp.concatenate([x1 * cos - x2 * sin, x2 * cos + x1 * sin], -1)


def rope_2d(x, ang):
    n = ang.shape[-1] // 2
    xr, xc = jnp.split(x, 2, axis=-1)
    return jnp.concatenate([_rotate(xr, ang[:, :n]), _rotate(xc, ang[:, n:])], -1)


def lambda_init(layer_idx):
    return 0.8 - 0.6 * math.exp(-0.3 * layer_idx)


def _split_qk(t):
    B, L, _ = t.shape
    t = t.reshape(B, L, DA_HEADS, 2, DA_HEAD_DIM)
    return t[..., 0, :], t[..., 1, :]


def diff_attention(q1, q2, k1, k2, v, lam):
    B, Lq, H, d = q1.shape
    nb = Lq // Q_BLOCK
    scale = d ** -0.5

    def to_blocks(q):
        return q.reshape(B, nb, Q_BLOCK, H, d).transpose(1, 0, 2, 3, 4)

    def block(qs):
        a1, a2 = qs
        s1 = jnp.einsum('bqhd,bkhd->bhqk', a1, k1).astype(F32) * scale
        s2 = jnp.einsum('bqhd,bkhd->bhqk', a2, k2).astype(F32) * scale
        p = jax.nn.softmax(s1, axis=-1) - lam * jax.nn.softmax(s2, axis=-1)
        return jnp.einsum('bhqk,bkhe->bqhe', p.astype(v.dtype), v)

    o = lax.map(block, (to_blocks(q1), to_blocks(q2)))
    return o.transpose(1, 0, 2, 3, 4).reshape(B, Lq, H, v.shape[-1])


def head_rmsnorm(o, g, post):
    of = o.astype(F32)
    y = of * lax.rsqrt(jnp.mean(of * of, -1, keepdims=True) + LN_EPS) * g.astype(F32) * post
    return y.astype(o.dtype)


def fourier_mix(f):
    B, L, _ = f.shape
    g = f.astype(F32).reshape(B, L, FN_GROUPS, FN_GW)
    return jnp.fft.fftn(g, axes=(1, 3), norm='ortho').real.reshape(B, L, FN_W).astype(f.dtype)


def diff_fourier_mixer(h_lat, h_ctx, w_in, w_out, lq1, lk1, lq2, lk2, subln_g, lam_init, ang, ctx_out):
    B, L, _ = h_lat.shape
    Lc = h_ctx.shape[1]
    lam = (jnp.exp(jnp.sum(lq1.astype(F32) * lk1.astype(F32)))
           - jnp.exp(jnp.sum(lq2.astype(F32) * lk2.astype(F32))) + lam_init)
    post = 1.0 - lam_init
    kv_c = h_ctx @ w_in[:, DA_W:3 * DA_W]
    k1c, k2c = _split_qk(kv_c[..., :DA_W])
    v_c = kv_c[..., DA_W:].reshape(B, Lc, DA_HEADS, 2 * DA_HEAD_DIM)
    p = h_lat @ w_in
    q, k, v, f = jnp.split(p, [DA_W, 2 * DA_W, 3 * DA_W], axis=-1)
    q1, q2 = _split_qk(q)
    k1, k2 = _split_qk(k)
    q1, q2, k1, k2 = rope_2d(q1, ang), rope_2d(q2, ang), rope_2d(k1, ang), rope_2d(k2, ang)
    v = v.reshape(B, L, DA_HEADS, 2 * DA_HEAD_DIM)
    K1 = jnp.concatenate([k1c, k1], axis=1)
    K2 = jnp.concatenate([k2c, k2], axis=1)
    V = jnp.concatenate([v_c, v], axis=1)
    o = head_rmsnorm(diff_attention(q1, q2, K1, K2, V, lam), subln_g, post).reshape(B, L, DA_W)
    y_lat = jnp.concatenate([o, fourier_mix(f)], axis=-1) @ w_out
    y_ctx = None
    if ctx_out:
        q1c, q2c = _split_qk(h_ctx @ w_in[:, :DA_W])
        oc = head_rmsnorm(diff_attention(q1c, q2c, k1c, k2c, v_c, lam), subln_g, post).reshape(B, Lc, DA_W)
        y_ctx = jnp.concatenate([oc, fourier_mix(h_ctx @ w_in[:, 3 * DA_W:])], axis=-1) @ w_out
    return y_lat, y_ctx


def hyena_filter_freq(L, w1, b1, w2, b2, w3, b3, freq, w4):
    t = jnp.linspace(0.0, 1.0, L, dtype=F32)[:, None]
    bands = (HY_FILTER_EMB - 1) // 2
    w = 2.0 * math.pi * jnp.arange(L, dtype=F32)[:, None] / L
    fb = jnp.linspace(1e-4, bands - 1, bands, dtype=F32)[None, :]
    z = jnp.concatenate([t, jnp.cos(fb * w), -jnp.sin(fb * w)], axis=-1)
    fr = freq.astype(F32)
    hdn = jnp.sin(fr * (z @ w1.astype(F32) + b1.astype(F32)))
    hdn = jnp.sin(fr * (hdn @ w2.astype(F32) + b2.astype(F32)))
    hdn = jnp.sin(fr * (hdn @ w3.astype(F32) + b3.astype(F32)))
    h = (hdn @ w4.astype(F32)).reshape(L, 2, D_MODEL)
    min_decay = math.log(HY_DECAY_TARGET) / HY_SLOW_DECAY
    max_decay = math.log(HY_DECAY_TARGET) / HY_FAST_DECAY
    deltas = jnp.abs(jnp.linspace(min_decay, max_decay, D_MODEL, dtype=F32))
    h = h * jnp.exp(-t * deltas)[:, None, :]
    hf, hb = h[:, 0], h[:, 1]
    k2 = jnp.concatenate([hf, jnp.zeros((1, D_MODEL), F32), hb[1:][::-1]], axis=0)
    k2 = k2 / jnp.sum(jnp.abs(k2), axis=0, keepdims=True)
    return jnp.fft.rfft(k2, axis=0)


def hyena_mixer(h, w_in, conv_w, conv_b, filt, d_skip, w_out):
    L = h.shape[1]
    u = dwconv3(h @ w_in, conv_w, conv_b)
    x0, x1, v = jnp.split(u, 3, axis=-1)
    v = v * x1
    k_f = hyena_filter_freq(L, *filt)
    vf = v.astype(F32)
    y = jnp.fft.irfft(jnp.fft.rfft(vf, n=2 * L, axis=1) * k_f[None], n=2 * L, axis=1)[:, :L]
    y = (y + vf * d_skip.astype(F32)).astype(h.dtype)
    return (y * x0) @ w_out


def conv_ffn(h, w_in, conv_w, conv_b, w_out):
    u = dwconv3(h @ w_in, conv_w, conv_b)
    a, g = jnp.split(u, 2, axis=-1)
    return (jax.nn.gelu(a, approximate=False) * g) @ w_out


def setup_inputs(seed: int = 0) -> dict:
    key = jax.random.key(seed)
    ks = jax.random.split(key, 34)
    n_even = (DEPTH + 1) // 2
    n_odd = DEPTH // 2
    beta = (8 * DEPTH) ** -0.25
    D = D_MODEL
    F = FFN_HIDDEN
    H = HY_FILTER_HIDDEN

    def nrm(k, shape, s):
        return jax.random.normal(k, shape, F32) * s

    return {
        'x': nrm(ks[0], (BATCH, SEQ, D), 1.0),
        'c': nrm(ks[1], (BATCH, D), 1.0),
        'ctx': nrm(ks[2], (BATCH, CTX_LEN, D), 1.0),
        'c_ctx': nrm(ks[3], (D,), 1.0),
        'mod_w': nrm(ks[4], (DEPTH, D, N_MOD * D), D ** -0.5),
        'mod_b': nrm(ks[5], (DEPTH, N_MOD * D), 0.02),
        'ln1_g': 1.0 + nrm(ks[6], (DEPTH, D), 0.02),
        'ln1_b': nrm(ks[7], (DEPTH, D), 0.02),
        'ln2_g': 1.0 + nrm(ks[8], (DEPTH, D), 0.02),
        'ln2_b': nrm(ks[9], (DEPTH, D), 0.02),
        'ffn_w_in': nrm(ks[10], (DEPTH, D, 2 * F), D ** -0.5),
        'ffn_conv_w': nrm(ks[11], (DEPTH, 3, 2 * F), 3 ** -0.5),
        'ffn_conv_b': nrm(ks[12], (DEPTH, 2 * F), 0.02),
        'ffn_w_out': nrm(ks[13], (DEPTH, F, D), beta * F ** -0.5),
        'da_w_in': nrm(ks[14], (n_even, D, 3 * DA_W + FN_W), D ** -0.5),
        'da_w_out': nrm(ks[15], (n_even, MIX_W, D), beta * MIX_W ** -0.5),
        'da_lam_q1': nrm(ks[16], (n_even, DA_HEAD_DIM), 0.1),
        'da_lam_k1': nrm(ks[17], (n_even, DA_HEAD_DIM), 0.1),
        'da_lam_q2': nrm(ks[18], (n_even, DA_HEAD_DIM), 0.1),
        'da_lam_k2': nrm(ks[19], (n_even, DA_HEAD_DIM), 0.1),
        'da_subln_g': 1.0 + nrm(ks[20], (n_even, 2 * DA_HEAD_DIM), 0.02),
        'hy_w_in': nrm(ks[21], (n_odd, D, 3 * MIX_W), D ** -0.5),
        'hy_conv_w': nrm(ks[22], (n_odd, 3, 3 * MIX_W), 3 ** -0.5),
        'hy_conv_b': nrm(ks[23], (n_odd, 3 * MIX_W), 0.02),
        'hy_f_w1': nrm(ks[24], (n_odd, HY_FILTER_EMB, H), HY_FILTER_EMB ** -0.5),
        'hy_f_b1': nrm(ks[25], (n_odd, H), 0.1),
        'hy_f_w2': nrm(ks[26], (n_odd, H, H), H ** -0.5),
        'hy_f_b2': nrm(ks[27], (n_odd, H), 0.1),
        'hy_f_w3': nrm(ks[28], (n_odd, H, H), H ** -0.5),
        'hy_f_b3': nrm(ks[29], (n_odd, H), 0.1),
        'hy_f_freq': 1.0 + nrm(ks[30], (n_odd, H), 0.1),
        'hy_f_w4': nrm(ks[31], (n_odd, H, 2 * MIX_W), H ** -0.5),
        'hy_d': nrm(ks[32], (n_odd, MIX_W), 1.0),
        'hy_w_out': nrm(ks[33], (n_odd, MIX_W, D), beta * MIX_W ** -0.5),
    }


def reference(x, c, ctx, c_ctx, mod_w, mod_b, ln1_g, ln1_b, ln2_g, ln2_b,
              ffn_w_in, ffn_conv_w, ffn_conv_b, ffn_w_out,
              da_w_in, da_w_out, da_lam_q1, da_lam_k1, da_lam_q2, da_lam_k2, da_subln_g,
              hy_w_in, hy_conv_w, hy_conv_b, hy_f_w1, hy_f_b1, hy_f_w2, hy_f_b2,
              hy_f_w3, hy_f_b3, hy_f_freq, hy_f_w4, hy_d, hy_w_out):
    n_lat = x.shape[1]
    rows = n_lat // GRID_W
    ang = axial_rope_angles(rows)
    alpha = (2 * DEPTH) ** 0.25
    for i in range(DEPTH):
        even = i % 2 == 0
        ctx_out = any(j % 2 == 0 for j in range(i + 1, DEPTH))
        sh1, sc1, g1, sh2, sc2, g2 = ada_params(c, mod_w[i], mod_b[i])
        h_lat = modulate(x, sh1, sc1)
        if even or ctx_out:
            csh1, csc1, cg1, csh2, csc2, cg2 = ada_params(c_ctx, mod_w[i], mod_b[i])
            h_ctx = modulate(ctx, csh1, csc1)
        if even:
            e = i // 2
            y_lat, y_ctx = diff_fourier_mixer(h_lat, h_ctx, da_w_in[e], da_w_out[e],
                                              da_lam_q1[e], da_lam_k1[e], da_lam_q2[e], da_lam_k2[e],
                                              da_subln_g[e], lambda_init(i), ang, ctx_out)
        else:
            o = i // 2
            filt = (hy_f_w1[o], hy_f_b1[o], hy_f_w2[o], hy_f_b2[o], hy_f_w3[o], hy_f_b3[o],
                    hy_f_freq[o], hy_f_w4[o])
            y_lat = hyena_mixer(h_lat, hy_w_in[o], hy_conv_w[o], hy_conv_b[o], filt, hy_d[o], hy_w_out[o])
            if ctx_out:
                y_ctx = hyena_mixer(h_ctx, hy_w_in[o], hy_conv_w[o], hy_conv_b[o], filt, hy_d[o], hy_w_out[o])
        ffn = (ffn_w_in[i], ffn_conv_w[i], ffn_conv_b[i], ffn_w_out[i])
        x = layer_norm(alpha * x + g1 * y_lat, ln1_g[i], ln1_b[i])
        x = layer_norm(alpha * x + g2 * conv_ffn(modulate(x, sh2, sc2), *ffn), ln2_g[i], ln2_b[i])
        if ctx_out:
            ctx = layer_norm(alpha * ctx + cg1 * y_ctx, ln1_g[i], ln1_b[i])
            ctx = layer_norm(alpha * ctx + cg2 * conv_ffn(modulate(ctx, csh2, csc2), *ffn), ln2_g[i], ln2_b[i])
    return x
```

```cpp
#include <hip/hip_runtime.h>
#include <hip/hip_bf16.h>
#include <hip/hip_cooperative_groups.h>
#include <cstdio>
namespace cg = cooperative_groups;

typedef unsigned short u16;
typedef __attribute__((ext_vector_type(8))) short bf16x8;
typedef __attribute__((ext_vector_type(4))) float f32x4;
typedef __attribute__((ext_vector_type(16))) float f32x16;

constexpr int D = 1024, NB = 4, L = 8192, LC = 256, LK = L + LC, M = NB * L;
constexpr int FF = 2816, NMOD = 6144;
constexpr int NTH = 512;
constexpr float ALPHA = 1.4142135623730951f;
constexpr float LN_EPS = 1e-5f;
constexpr float QSCALE = 0.125f * 1.4426950408889634f;

constexpr size_t AL256(size_t x) { return (x + 255) & ~(size_t)255; }
constexpr size_t WS_W1T = 0;
constexpr size_t WS_W2T = WS_W1T + (size_t)2560 * 1024 * 2;
constexpr size_t WS_W3T = WS_W2T + (size_t)1024 * 1024 * 2;
constexpr size_t WS_W4T = WS_W3T + (size_t)2 * 5632 * 1024 * 2;
constexpr size_t WS_W5T = WS_W4T + (size_t)2 * 1024 * 2816 * 2;
constexpr size_t WS_W6T = WS_W5T + (size_t)3072 * 1024 * 2;
constexpr size_t WS_MODV = WS_W6T + (size_t)1024 * 1024 * 2;
constexpr size_t WS_MISC = WS_MODV + AL256((size_t)2 * 5 * NMOD * 4);
constexpr size_t WS_BAR = WS_MISC + 256;
constexpr size_t WS_ZROW = WS_BAR + 16 * 256;
constexpr size_t WS_ROPE = WS_ZROW + 2048;
constexpr size_t WS_HT = WS_ROPE + (size_t)128 * 16 * 8 + 256;
constexpr size_t WS_HA = WS_HT + (size_t)2 * 1024 * 8192 * 4;
constexpr size_t WS_RX = WS_HA + (size_t)33792 * 1024 * 2;
constexpr size_t WS_E = WS_RX + (size_t)M * 1024 * 4;
constexpr size_t WS_Q = WS_E;
constexpr size_t WS_K = WS_Q + (size_t)NB * 4 * 2 * L * 64 * 2;
constexpr size_t WS_VT = WS_K + (size_t)NB * 4 * 2 * LK * 64 * 2;
constexpr size_t WS_FZ = WS_VT + (size_t)NB * 4 * 128 * LK * 2;
constexpr size_t WS_H = WS_E;
constexpr size_t WS_VXT = WS_E;
constexpr size_t WS_X0T = WS_VXT + (size_t)NB * 1024 * L * 2;
constexpr size_t WS_KSPEC = WS_X0T + (size_t)NB * 1024 * L * 2;
constexpr size_t WS_END = WS_E + (size_t)M * FF * 2;
static_assert(WS_KSPEC + (size_t)256 * 16384 * 8 <= WS_END, "kspec fits");
constexpr size_t WS_O = WS_HA;
constexpr size_t WS_YT = WS_HA + (size_t)M * 512 * 2;
constexpr size_t WS_GT = WS_HA;

#ifndef DUP_PHASE
#define DUP_PHASE -1
#endif
#ifndef DUP_FLAGS
#define DUP_FLAGS 0
#endif
constexpr int LDS_BYTES = 131072 + 256;

struct Params {
  const float* in[34];
  float* out;
  char* ws;
  int ph_lo, ph_hi, flags, pad_;
};

__device__ __forceinline__ unsigned cvtpk(float lo, float hi) {
  unsigned r; asm volatile("v_cvt_pk_bf16_f32 %0, %1, %2" : "=v"(r) : "v"(lo), "v"(hi)); return r;
}
__device__ __forceinline__ u16 f2bf(float f) { return (u16)(cvtpk(f, 0.f) & 0xffffu); }
__device__ __forceinline__ float bf2f(unsigned h) { return __uint_as_float(h << 16); }
__device__ __forceinline__ float bflo(unsigned v) { return __uint_as_float(v << 16); }
__device__ __forceinline__ float bfhi(unsigned v) { return __uint_as_float(v & 0xffff0000u); }
__device__ __forceinline__ float wave_sum(float v) {
#pragma unroll
  for (int o = 32; o >= 1; o >>= 1) v += __shfl_xor(v, o);
  return v;
}
__device__ __forceinline__ float swap32_f(float v) {
  return __shfl_xor(v, 32);
}
__device__ __forceinline__ int swz16(int row, int c) { return row * 128 + ((c ^ ((row >> 1) & 7)) << 4); }

__device__ __forceinline__ void glds16(const u16* g, char* lds_wave_base) {
  __builtin_amdgcn_global_load_lds((const unsigned*)g, (__attribute__((address_space(3))) unsigned*)lds_wave_base, 16, 0, 0);
}
__device__ __forceinline__ void glds16u(const char* ubase, unsigned voff, char* lds_wave_base) {
  __builtin_amdgcn_global_load_lds((const unsigned*)(ubase + voff), (__attribute__((address_space(3))) unsigned*)lds_wave_base, 16, 0, 0);
}
struct ALPlain {
  const u16* base; int lda;
  __device__ __forceinline__ void issue(int kt, char* Ab) {
    const int tid = threadIdx.x; const int c = (tid & 7) ^ ((tid >> 4) & 7);
    const int wvb = __builtin_amdgcn_readfirstlane((tid >> 6) << 10);
    const unsigned voff = ((unsigned)(tid >> 3) * lda + c * 8) * 2;
#pragma unroll
    for (int i = 0; i < 2; ++i) glds16u((const char*)(base + (size_t)(64 * i) * lda + kt * 64), voff, Ab + wvb + i * 8192);
  }
  __device__ __forceinline__ void commit(char* Ab) {}
};
struct ALHalo {
  const char* wsb; unsigned hoff  ; int t0;
  __device__ __forceinline__ void issue(int kt, char* Ab) {
    const int tid = threadIdx.x; const int c = (tid & 7) ^ ((tid >> 4) & 7);
    const int wvb = __builtin_amdgcn_readfirstlane((tid >> 6) << 10);
#pragma unroll
    for (int i = 0; i < 2; ++i) {
      int row = (tid >> 3) + 64 * i; int t = t0 + row;
      unsigned off = (t >= 0 && t < L) ? hoff + ((unsigned)t * D + kt * 64 + c * 8) * 2 : (unsigned)WS_ZROW + c * 16;
      glds16u(wsb, off, Ab + wvb + i * 8192);
    }
  }
  __device__ __forceinline__ void commit(char* Ab) {}
};
__device__ __forceinline__ void trans_load(const u16* src  , uint2 (&r)[4]) {
  const int tid = threadIdx.x, kq = tid >> 5, mq = tid & 31;
#pragma unroll
  for (int i = 0; i < 4; ++i) r[i] = *(const uint2*)(src + (size_t)(4 * kq + i) * L + 4 * mq);
}
__device__ __forceinline__ void trans_store(char* Ab, const uint2 (&r)[4]) {
  const int tid = threadIdx.x, kq = tid >> 5, mq = tid & 31;
  uint2 o[4];
  o[0].x = (r[0].x & 0xffffu) | (r[1].x << 16); o[0].y = (r[2].x & 0xffffu) | (r[3].x << 16);
  o[1].x = (r[0].x >> 16) | (r[1].x & 0xffff0000u); o[1].y = (r[2].x >> 16) | (r[3].x & 0xffff0000u);
  o[2].x = (r[0].y & 0xffffu) | (r[1].y << 16); o[2].y = (r[2].y & 0xffffu) | (r[3].y << 16);
  o[3].x = (r[0].y >> 16) | (r[1].y & 0xffff0000u); o[3].y = (r[2].y >> 16) | (r[3].y & 0xffff0000u);
#pragma unroll
  for (int j = 0; j < 4; ++j) { int row = 4 * mq + j; *(uint2*)(Ab + swz16(row, kq >> 1) + (kq & 1) * 8) = o[j]; }
}
struct ALTrans {
  const u16* base; uint2 r[4];
  __device__ __forceinline__ void issue(int kt, char* Ab) { trans_load(base + (size_t)kt * 64 * L, r); }
  __device__ __forceinline__ void commit(char* Ab) { trans_store(Ab, r); }
};
struct ALCat {
  const u16* obase; const u16* ybase; uint4 r[2]; int last;
  __device__ __forceinline__ void issue(int kt, char* Ab) {
    last = kt;
    const int tid = threadIdx.x;
    if (kt < 8) {
#pragma unroll
      for (int i = 0; i < 2; ++i) { int row = (tid >> 3) + 64 * i; r[i] = *(const uint4*)(obase + (size_t)row * 512 + kt * 64 + (tid & 7) * 8); }
    } else {
      const int kq = tid >> 5, mq = tid & 31;
      const u16* src = ybase + (size_t)(kt - 8) * 64 * L + (size_t)(4 * kq) * L + 4 * mq;
      uint2 a = *(const uint2*)(src), b = *(const uint2*)(src + L), c = *(const uint2*)(src + 2 * L), d = *(const uint2*)(src + 3 * L);
      r[0] = make_uint4(a.x, a.y, b.x, b.y); r[1] = make_uint4(c.x, c.y, d.x, d.y);
    }
  }
  __device__ __forceinline__ void commit(char* Ab) {
    const int tid = threadIdx.x;
    if (last < 8) {
#pragma unroll
      for (int i = 0; i < 2; ++i) { int row = (tid >> 3) + 64 * i; *(uint4*)(Ab + swz16(row, tid & 7)) = r[i]; }
    } else {
      uint2 q[4] = {make_uint2(r[0].x, r[0].y), make_uint2(r[0].z, r[0].w), make_uint2(r[1].x, r[1].y), make_uint2(r[1].z, r[1].w)};
      trans_store(Ab, q);
    }
  }
};

#define SB() __builtin_amdgcn_sched_barrier(0)
template <int NF, class AL, class EP>
__device__ __forceinline__ void gemm_tile(char* smem, AL& al, const u16* __restrict__ Bt, int K, EP& ep) {
  constexpr int ASZ = 16384, BSZ = 16384 * NF, STG = ASZ + BSZ;
  const int tid = threadIdx.x, w = tid >> 6, l = tid & 63, fr = l & 15, fq = l >> 4;
  f32x4 acc[8][NF];
#pragma unroll
  for (int i = 0; i < 8; ++i)
#pragma unroll
    for (int j = 0; j < NF; ++j) acc[i][j] = f32x4{0.f, 0.f, 0.f, 0.f};
  const int KT = K >> 6;
  const int wvb = __builtin_amdgcn_readfirstlane((tid >> 6) << 10);
  const unsigned bvoff = ((unsigned)(tid >> 3) * K + ((tid & 7) ^ ((tid >> 4) & 7)) * 8) * 2;
  auto issueB = [&](int kt, char* Bb) {
#pragma unroll
    for (int i = 0; i < 2 * NF; ++i) glds16u((const char*)(Bt + (size_t)(64 * i) * K + kt * 64), bvoff, Bb + wvb + i * 8192);
  };
  bf16x8 A0[4], A1[4], B0[NF], B1[NF];
  auto rdA = [&](bf16x8 (&a)[4], const char* buf, int ks, int mh) {
#pragma unroll
    for (int mf = 0; mf < 4; ++mf) a[mf] = *(const bf16x8*)(buf + swz16((mh * 4 + mf) * 16 + fr, ks * 4 + fq));
  };
  auto rdB = [&](bf16x8 (&b)[NF], const char* buf, int ks) {
#pragma unroll
    for (int nf = 0; nf < NF; ++nf) b[nf] = *(const bf16x8*)(buf + ASZ + swz16(w * 16 * NF + nf * 16 + fr, ks * 4 + fq));
  };
#define MM(a, b, mh) _Pragma("unroll") for (int mf = 0; mf < 4; ++mf) _Pragma("unroll") for (int nf = 0; nf < NF; ++nf) \
    acc[(mh) * 4 + mf][nf] = __builtin_amdgcn_mfma_f32_16x16x32_bf16(a[mf], b[nf], acc[(mh) * 4 + mf][nf], 0, 0, 0);
  al.issue(0, smem); issueB(0, smem + ASZ); al.commit(smem);
  asm volatile("s_waitcnt vmcnt(0)" ::: "memory");
  __syncthreads();
  rdA(A0, smem, 0, 0); rdB(B0, smem, 0);
  for (int kt = 0; kt < KT; ++kt) {
    char* cur = smem + (kt & 1) * STG; char* nxt = smem + ((kt + 1) & 1) * STG;
    const bool more = kt + 1 < KT;
    if (more) { al.issue(kt + 1, nxt); issueB(kt + 1, nxt + ASZ); }
    rdA(A1, cur, 0, 1); SB();
    MM(A0, B0, 0) SB();
    rdA(A0, cur, 1, 0); rdB(B1, cur, 1); SB();
    MM(A1, B0, 1) SB();
    rdA(A1, cur, 1, 1); SB();
    MM(A0, B1, 0) SB();
    if (more) al.commit(nxt);
    asm volatile("s_waitcnt vmcnt(0) lgkmcnt(0)" ::: "memory");
    __syncthreads();
    if (more) { rdA(A0, nxt, 0, 0); rdB(B0, nxt, 0); }
    SB();
    MM(A1, B1, 1) SB();
  }
#undef MM
  ep.template run<NF, 0>(acc, w);
}

template <int NF, class AL, class EP>
__device__ __forceinline__ void gemm_tile2(char* smem, AL& al0, AL& al1, const u16* __restrict__ Bt, int K, EP& ep0, EP& ep1, int flags = 0) {
  constexpr int ASZ = 32768, STG = ASZ + 8192 * NF;
  int tid = threadIdx.x; asm volatile("" : "+v"(tid));
  const int w = tid >> 6, l = tid & 63, fr = l & 15, fq = l >> 4, mg = w >> 2, wn = w & 3;
  f32x4 acc[8][NF];
#pragma unroll
  for (int i = 0; i < 8; ++i)
#pragma unroll
    for (int j = 0; j < NF; ++j) acc[i][j] = f32x4{0.f, 0.f, 0.f, 0.f};
  const int KT = K >> 6;
  const int wvb = __builtin_amdgcn_readfirstlane((tid >> 6) << 10);
  const unsigned bvoff = ((unsigned)(tid >> 3) * K + ((tid & 7) ^ ((tid >> 4) & 7)) * 8) * 2;
  auto issueB = [&](int kt, char* Bb) {
#pragma unroll
    for (int i = 0; i < NF; ++i) glds16u((const char*)(Bt + (size_t)(64 * i) * K + kt * 64), bvoff, Bb + wvb + i * 8192);
  };
  auto issueBh = [&](int kt, char* Bb, int h) {
#pragma unroll
    for (int i = 0; i < NF; ++i) if ((i >> 1) == h) glds16u((const char*)(Bt + (size_t)(64 * i) * K + kt * 64), bvoff, Bb + wvb + i * 8192);
  };
  bf16x8 Aa[2], Ab[2], B0[NF], B1[NF];
  auto rdA = [&](bf16x8 (&a)[2], const char* buf, int ks, int mp) {
#pragma unroll
    for (int i = 0; i < 2; ++i) a[i] = *(const bf16x8*)(buf + mg * 16384 + swz16((mp * 2 + i) * 16 + fr, ks * 4 + fq));
  };
  auto rdB = [&](bf16x8 (&b)[NF], const char* buf, int ks) {
#pragma unroll
    for (int nf = 0; nf < NF; ++nf) b[nf] = *(const bf16x8*)(buf + ASZ + swz16(wn * 16 * NF + nf * 16 + fr, ks * 4 + fq));
  };
#define MM(a, b, mp) _Pragma("unroll") for (int i = 0; i < 2; ++i) _Pragma("unroll") for (int nf = 0; nf < NF; ++nf) \
    acc[(mp) * 2 + i][nf] = __builtin_amdgcn_mfma_f32_16x16x32_bf16(a[i], b[nf], acc[(mp) * 2 + i][nf], 0, 0, 0);
  al0.issue(0, smem); al1.issue(0, smem + 16384); issueB(0, smem + ASZ); al0.commit(smem); al1.commit(smem + 16384);
  asm volatile("s_waitcnt vmcnt(0)" ::: "memory");
  __syncthreads();
  rdA(Aa, smem, 0, 0); rdB(B0, smem, 0);
  for (int kt = 0; kt < KT; ++kt) {
    char* cur = smem + (kt & 1) * STG; char* nxt = smem + ((kt + 1) & 1) * STG;
    const bool more = kt + 1 < KT;
    const bool ld = more && !(flags & 1);
    if (ld) { al0.issue(kt + 1, nxt); al1.issue(kt + 1, nxt + 16384); }
    rdA(Ab, cur, 0, 1); SB(); MM(Aa, B0, 0) SB();
    rdA(Aa, cur, 0, 2); if (ld) issueB(kt + 1, nxt + ASZ); SB(); MM(Ab, B0, 1) SB();
    rdA(Ab, cur, 0, 3); rdB(B1, cur, 1); SB(); MM(Aa, B0, 2) SB();
    rdA(Aa, cur, 1, 0); SB(); MM(Ab, B0, 3) SB();
    rdA(Ab, cur, 1, 1); SB(); MM(Aa, B1, 0) SB();
    rdA(Aa, cur, 1, 2); SB(); MM(Ab, B1, 1) SB();
    rdA(Ab, cur, 1, 3); SB(); MM(Aa, B1, 2) SB();
    if (more) { al0.commit(nxt); al1.commit(nxt + 16384); }
    asm volatile("s_waitcnt vmcnt(0) lgkmcnt(0)" ::: "memory");
    __syncthreads();
    if (more) { rdA(Aa, nxt, 0, 0); rdB(B0, nxt, 0); }
    SB();
    MM(Ab, B1, 3) SB();
  }
#undef MM
  if (!(flags & 2)) {
    int t2 = threadIdx.x; asm volatile("" : "+v"(t2));
    const int wn2 = (t2 >> 6) & 3;
    if (NF == 4) {
      if ((t2 >> 8) == 0) { ep0.template run<NF, 0>(acc, wn2 * 2); ep0.template run<NF, NF - 2>(acc, wn2 * 2 + 1); }
      else { ep1.template run<NF, 0>(acc, wn2 * 2); ep1.template run<NF, NF - 2>(acc, wn2 * 2 + 1); }
    } else {
      if ((t2 >> 8) == 0) ep0.template run<NF, 0>(acc, wn2); else ep1.template run<NF, 0>(acc, wn2);
    }
  }
}

struct Epi1 {
  char* ws; int nt, b, t0; bool ctx;
  template <int NFT, int F0>
  __device__ __forceinline__ void run(f32x4 (&acc)[8][NFT], int w) {
    int tid = threadIdx.x; asm volatile("" : "+v"(tid));
    const int l = tid & 63, c = l & 15, q4 = l >> 4;
    if (nt < 4) {
      const bool isq = nt < 2;
      const int head = (nt & 1) * 2 + (w >> 2), comp = (w >> 1) & 1, dh = w & 1;
      const float2* rope = (const float2*)(ws + WS_ROPE);
      u16* dst;
      if (isq) { dst = (u16*)(ws + WS_Q) + ((size_t)((b * 4 + head) * 2 + comp) * L + t0) * 64; }
      else { dst = (u16*)(ws + WS_K) + ((size_t)((b * 4 + head) * 2 + comp) * LK + (ctx ? t0 : LC + t0)) * 64; }
      const float sc = isq ? QSCALE : 1.f;
      const unsigned d1 = dh * 32 + c;
#pragma unroll
      for (int mf = 0; mf < 8; ++mf) {
#pragma unroll
        for (int j = 0; j < 4; ++j) {
          unsigned r = mf * 16 + q4 * 4 + j;
          float x1 = acc[mf][F0][j], x2 = acc[mf][F0 + 1][j], o1, o2;
          unsigned t = t0 + r; unsigned pos = dh ? (t & 63) : (t >> 6);
          float2 cs = rope[ctx ? 2048u : pos * 16 + c];
          o1 = x1 * cs.x - x2 * cs.y; o2 = x2 * cs.x + x1 * cs.y;
          dst[r * 64 + d1] = f2bf(o1 * sc);
          dst[r * 64 + d1 + 16] = f2bf(o2 * sc);
        }
        __builtin_amdgcn_sched_barrier(0);
      }
    } else if (nt < 6) {
      const int head = (nt - 4) * 2 + (w >> 2);
      u16* vt = (u16*)(ws + WS_VT);
#pragma unroll
      for (int f = 0; f < 2; ++f) {
        int e = (w & 3) * 32 + f * 16 + c;
        u16* dst = vt + ((size_t)(b * 4 + head) * 128 + e) * LK + (ctx ? t0 : LC + t0);
#pragma unroll
        for (int mf = 0; mf < 8; ++mf) {
          uint2 v; v.x = cvtpk(acc[mf][F0 + f][0], acc[mf][F0 + f][1]); v.y = cvtpk(acc[mf][F0 + f][2], acc[mf][F0 + f][3]);
          *(uint2*)(dst + mf * 16 + q4 * 4) = v;
        }
      }
    } else {
      const int ch = (nt - 6) * 128 + w * 16 + c;
      unsigned* dst = (unsigned*)(ws + WS_FZ) + ((size_t)(b * 512 + ch)) * L + t0;
#pragma unroll
      for (int mf = 0; mf < 8; ++mf) {
        uint4 v;
        v.x = cvtpk(acc[mf][F0][0], acc[mf][F0 + 1][0]); v.y = cvtpk(acc[mf][F0][1], acc[mf][F0 + 1][1]);
        v.z = cvtpk(acc[mf][F0][2], acc[mf][F0 + 1][2]); v.w = cvtpk(acc[mf][F0][3], acc[mf][F0 + 1][3]);
        *(uint4*)(dst + mf * 16 + q4 * 4) = v;
      }
    }
  }
};
__device__ __forceinline__ float dpp_xor1(float v) {
  return __int_as_float(__builtin_amdgcn_mov_dpp(__float_as_int(v), 0xB1, 0xF, 0xF, true));
}
struct EpiRes {
  const float* Xf; const u16* X16; u16* R; const float* gate; int m0, n0;
  template <int NFT, int F0>
  __device__ __forceinline__ void run(f32x4 (&acc)[8][NFT], int w) {
    int tid = threadIdx.x; asm volatile("" : "+v"(tid));
    const int l = tid & 63, c = l & 15, q4 = l >> 4;
    const bool odd = c & 1;
#pragma unroll
    for (int f = 0; f < 2; ++f) {
      const int np = n0 + w * 32 + f * 16 + (c & ~1);
      const float g0 = gate[np], g1 = gate[np + 1];
      const unsigned base = (unsigned)(m0 + q4 * 4 + (odd ? 2 : 0)) * D + np;
#pragma unroll
      for (int mf = 0; mf < 8; ++mf) {
        const float a0 = acc[mf][F0 + f][0], a1 = acc[mf][F0 + f][1], a2 = acc[mf][F0 + f][2], a3 = acc[mf][F0 + f][3];
        const float r0 = dpp_xor1(odd ? a0 : a2), r1 = dpp_xor1(odd ? a1 : a3);
        const float v00 = odd ? r0 : a0, v01 = odd ? a2 : r0;
        const float v10 = odd ? r1 : a1, v11 = odd ? a3 : r1;
        const unsigned i0 = base + (unsigned)(mf * 16) * D, i1 = i0 + D;
        float x00, x01, x10, x11;
        if (Xf) { float2 t0 = *(const float2*)(Xf + i0), t1 = *(const float2*)(Xf + i1); x00 = t0.x; x01 = t0.y; x10 = t1.x; x11 = t1.y; }
        else { unsigned t0 = *(const unsigned*)(X16 + i0), t1 = *(const unsigned*)(X16 + i1); x00 = bflo(t0); x01 = bfhi(t0); x10 = bflo(t1); x11 = bfhi(t1); }
        *(unsigned*)(R + i0) = cvtpk(ALPHA * x00 + g0 * v00, ALPHA * x01 + g1 * v01);
        *(unsigned*)(R + i1) = cvtpk(ALPHA * x10 + g0 * v10, ALPHA * x11 + g1 * v11);
        __builtin_amdgcn_sched_barrier(0);
      }
    }
  }
};
__device__ __forceinline__ float gelu_erf(float x) {
  float z = fabsf(x) * 0.70710678118654752f;
  float t = __builtin_amdgcn_rcpf(1.f + 0.3275911f * z);
  float poly = t * (0.254829592f + t * (-0.284496736f + t * (1.421413741f + t * (-1.453152027f + t * 1.061405429f))));
  float er = 1.f - poly * __builtin_amdgcn_exp2f(-z * z * 1.4426950408889634f);
  er = copysignf(er, x);
  return 0.5f * x * (1.f + er);
}
typedef float f32x2 __attribute__((ext_vector_type(2)));
__device__ __forceinline__ f32x2 gelu2_gate(f32x2 x, f32x2 g) {
  f32x2 ax; ax.x = fabsf(x.x); ax.y = fabsf(x.y);
  f32x2 z = ax * 0.70710678118654752f;
  f32x2 den = z * 0.3275911f + 1.f;
  f32x2 t; t.x = __builtin_amdgcn_rcpf(den.x); t.y = __builtin_amdgcn_rcpf(den.y);
  f32x2 poly = t * 1.061405429f + (-1.453152027f);
  poly = poly * t + 1.421413741f; poly = poly * t + (-0.284496736f); poly = poly * t + 0.254829592f; poly = poly * t;
  f32x2 ez = z * z * (-1.4426950408889634f);
  f32x2 e; e.x = __builtin_amdgcn_exp2f(ez.x); e.y = __builtin_amdgcn_exp2f(ez.y);
  f32x2 er = 1.f - poly * e;
  er.x = copysignf(er.x, x.x); er.y = copysignf(er.y, x.y);
  f32x2 hx = x * 0.5f;
  return (hx * er + hx) * g;
}
template <int NF>
__device__ __forceinline__ void conv_rows(f32x4 (&acc)[8][NF], int f, float w0, float w1, float w2, float bias, f32x4 (&out)[8]) {
  int tl_ = threadIdx.x; asm volatile("" : "+v"(tl_));
  const int l = tl_ & 63, q4 = l >> 4;
#pragma unroll
  for (int mf = 0; mf < 8; ++mf) {
    float sp = (q4 == 3) ? (mf > 0 ? acc[mf > 0 ? mf - 1 : 0][f][3] : 0.f) : acc[mf][f][3];
    float sn = (q4 == 0) ? (mf < 7 ? acc[mf < 7 ? mf + 1 : 7][f][0] : 0.f) : acc[mf][f][0];
    float prev = __shfl(sp, (l - 16) & 63);
    float next = __shfl(sn, (l + 16) & 63);
    float u0 = acc[mf][f][0], u1 = acc[mf][f][1], u2 = acc[mf][f][2], u3 = acc[mf][f][3];
    out[mf][0] = w0 * prev + w1 * u0 + w2 * u1 + bias;
    out[mf][1] = w0 * u0 + w1 * u1 + w2 * u2 + bias;
    out[mf][2] = w0 * u1 + w1 * u2 + w2 * u3 + bias;
    out[mf][3] = w0 * u2 + w1 * u3 + w2 * next + bias;
  }
}
struct EpiFfn {
  u16* H; const float* cw; const float* cb; int b, tbase, nt;
  template <int NFT, int F0>
  __device__ __forceinline__ void run(f32x4 (&acc)[8][NFT], int w) {
    int tid = threadIdx.x; asm volatile("" : "+v"(tid));
    const int l = tid & 63, c = l & 15, q4 = l >> 4;
    const int ch = nt * 128 + w * 16 + c;
    f32x4 a[8], g[8];
    conv_rows<NFT>(acc, F0, cw[ch], cw[2 * FF + ch], cw[4 * FF + ch], cb[ch], a);
    conv_rows<NFT>(acc, F0 + 1, cw[FF + ch], cw[3 * FF + ch], cw[5 * FF + ch], cb[FF + ch], g);
#pragma unroll
    for (int mf = 0; mf < 8; ++mf) {
      f32x2 h01 = gelu2_gate(f32x2{a[mf][0], a[mf][1]}, f32x2{g[mf][0], g[mf][1]});
      f32x2 h23 = gelu2_gate(f32x2{a[mf][2], a[mf][3]}, f32x2{g[mf][2], g[mf][3]});
      const float hv[4] = {h01.x, h01.y, h23.x, h23.y};
#pragma unroll
      for (int j = 0; j < 4; ++j) {
        int r = mf * 16 + q4 * 4 + j; int t = tbase + r;
        if (r >= 1 && r <= 126 && t < L) H[((size_t)b * L + t) * FF + ch] = f2bf(hv[j]);
      }
    }
  }
};
struct EpiHy {
  u16* VXT; u16* X0T; const float* cw; const float* cb; int b, tbase, nt;
  template <int NFT, int F0>
  __device__ __forceinline__ void run(f32x4 (&acc)[8][NFT], int w) {
    int tid = threadIdx.x; asm volatile("" : "+v"(tid));
    const int l = tid & 63, c = l & 15, q4 = l >> 4;
    const int ch = nt * 64 + w * 16 + c;
    f32x4 x0[8], x1[8], v[8];
    conv_rows<3>(acc, 0, cw[ch], cw[3072 + ch], cw[6144 + ch], cb[ch], x0);
    conv_rows<3>(acc, 1, cw[1024 + ch], cw[3072 + 1024 + ch], cw[6144 + 1024 + ch], cb[1024 + ch], x1);
    conv_rows<3>(acc, 2, cw[2048 + ch], cw[3072 + 2048 + ch], cw[6144 + 2048 + ch], cb[2048 + ch], v);
    u16* vd = VXT + ((size_t)b * 1024 + ch) * L;
    u16* xd = X0T + ((size_t)b * 1024 + ch) * L;
#pragma unroll
    for (int mf = 0; mf < 8; ++mf)
#pragma unroll
      for (int pr = 0; pr < 2; ++pr) {
        int r = mf * 16 + q4 * 4 + pr * 2; int t = tbase + r;
        if (r >= 2 && r < 126 && t < L) {
          *(unsigned*)(vd + t) = cvtpk(v[mf][pr * 2] * x1[mf][pr * 2], v[mf][pr * 2 + 1] * x1[mf][pr * 2 + 1]);
          *(unsigned*)(xd + t) = cvtpk(x0[mf][pr * 2], x0[mf][pr * 2 + 1]);
        }
      }
  }
};

__device__ __forceinline__ void phase_gemm1(const Params& p, char* smem) {
  char* ws = p.ws;
  const u16* HA = (const u16*)(ws + WS_HA);
  const u16* W = (const u16*)(ws + WS_W1T);
  const bool xs = (gridDim.x == 256);
  const int xcd = blockIdx.x & 7, jb = blockIdx.x >> 3;
  for (int tt = xs ? jb : blockIdx.x; tt < (xs ? 162 : 1296); tt += xs ? 32 : gridDim.x) {
    int pi, nt;
    if (xs) {
      if (tt < 160) { nt = tt % 10; pi = xcd * 16 + tt / 10; } else { pi = 128 + (xcd >> 1); nt = 2 + (xcd & 1) * 2 + (tt - 160); }
    } else { int idx = tt; if (idx < 1280) { nt = idx % 10; pi = idx / 10; } else { int j = idx - 1280; pi = 128 + (j >> 2); nt = 2 + (j & 3); } }
    Epi1 ep[2]; ALPlain al[2];
#pragma unroll
    for (int g = 0; g < 2; ++g) {
      int mt = 2 * pi + g;
      ep[g].ws = ws; ep[g].nt = nt;
      if (mt < 256) { ep[g].ctx = false; ep[g].b = mt >> 6; ep[g].t0 = (mt & 63) * 128; }
      else { ep[g].ctx = true; ep[g].b = (mt - 256) >> 1; ep[g].t0 = ((mt - 256) & 1) * 128; }
      al[g].base = HA + (size_t)mt * 128 * D; al[g].lda = D;
    }
    gemm_tile2<4>(smem, al[0], al[1], W + (size_t)nt * 256 * D, D, ep[0], ep[1]);
  }
}
template <int AMODE>
__device__ __forceinline__ void phase_gemm_res(const Params& p, char* smem, const u16* A, int K, const u16* Wt, const float* Xf, const u16* X16, u16* R, int gate_layer, int gate_off) {
  char* ws = p.ws;
  const bool xs = (gridDim.x == 256);
  const int xcd = blockIdx.x & 7, jb = blockIdx.x >> 3;
  for (int tt = xs ? jb : blockIdx.x; tt < (xs ? 64 : 512); tt += xs ? 32 : gridDim.x) {
    int idx = xs ? xcd * 64 + tt : tt;
    int nt = idx & 3, pi = idx >> 2;
    int b = pi >> 5;
    EpiRes ep[2];
#pragma unroll
    for (int g = 0; g < 2; ++g) {
      ep[g].Xf = Xf; ep[g].X16 = X16; ep[g].R = R; ep[g].m0 = (2 * pi + g) * 128; ep[g].n0 = nt * 256;
      ep[g].gate = (const float*)(ws + WS_MODV) + ((size_t)gate_layer * 5 + b) * NMOD + gate_off;
    }
    const u16* Bt = Wt + (size_t)nt * 256 * K;
    if (AMODE == 0) {
      ALPlain al[2];
#pragma unroll
      for (int g = 0; g < 2; ++g) { al[g].base = A + (size_t)(2 * pi + g) * 128 * K; al[g].lda = K; }
      gemm_tile2<4>(smem, al[0], al[1], Bt, K, ep[0], ep[1], p.flags);
    } else if (AMODE == 1) {
      ALCat al[2];
#pragma unroll
      for (int g = 0; g < 2; ++g) {
        int mt = 2 * pi + g; int t0 = (mt & 63) * 128;
        al[g].obase = (const u16*)(ws + WS_O) + (size_t)mt * 128 * 512; al[g].ybase = (const u16*)(ws + WS_YT) + (size_t)b * 512 * L + t0; al[g].last = 0;
      }
      gemm_tile2<4>(smem, al[0], al[1], Bt, K, ep[0], ep[1]);
    } else {
      ALTrans al[2];
#pragma unroll
      for (int g = 0; g < 2; ++g) { int mt = 2 * pi + g; int t0 = (mt & 63) * 128; al[g].base = A + (size_t)b * 1024 * L + t0; }
      gemm_tile2<4>(smem, al[0], al[1], Bt, K, ep[0], ep[1]);
    }
  }
}
__device__ __forceinline__ void phase_gemm_ffn_in(const Params& p, char* smem, int layer) {
  char* ws = p.ws;
  const u16* HA = (const u16*)(ws + WS_HA);
  const u16* W = (const u16*)(ws + WS_W3T) + (size_t)layer * 5632 * 1024;
  const bool xs = (gridDim.x == 256);
  const int xcd = blockIdx.x & 7, jb = blockIdx.x >> 3;
  for (int tt = xs ? jb : blockIdx.x; tt < (xs ? 363 : 132 * 22); tt += xs ? 32 : gridDim.x) {
    int nt, pi;
    if (xs) { pi = (xcd & 3) * 33 + tt / 11; nt = (xcd >> 2) * 11 + tt % 11; }
    else { nt = tt % 22; pi = tt / 22; }
    int b = pi / 33;
    EpiFfn ep[2]; ALHalo al[2];
#pragma unroll
    for (int g = 0; g < 2; ++g) {
      int i = (2 * pi + g) - b * 66;
      ep[g].H = (u16*)(ws + WS_H); ep[g].cw = p.in[11] + (size_t)layer * 3 * 2 * FF; ep[g].cb = p.in[12] + (size_t)layer * 2 * FF;
      ep[g].b = b; ep[g].tbase = 126 * i - 1; ep[g].nt = nt;
      al[g].wsb = ws; al[g].hoff = (unsigned)(WS_HA + (size_t)b * L * D * 2); al[g].t0 = ep[g].tbase;
    }
    gemm_tile2<4>(smem, al[0], al[1], W + (size_t)nt * 256 * D, D, ep[0], ep[1], p.flags);
  }
}
__device__ __forceinline__ void phase_gemm_hy_in(const Params& p, char* smem) {
  char* ws = p.ws;
  const u16* W = (const u16*)(ws + WS_W5T);
  const bool xs = (gridDim.x == 256);
  const int xcd = blockIdx.x & 7, jb = blockIdx.x >> 3;
  for (int tt = xs ? jb : blockIdx.x; tt < (xs ? 272 : 136 * 16); tt += xs ? 32 : gridDim.x) {
    int nt, pi;
    if (xs) { pi = (xcd & 3) * 34 + (tt >> 3); nt = (xcd >> 2) * 8 + (tt & 7); }
    else { nt = tt & 15; pi = tt >> 4; }
    int b = pi / 34;
    EpiHy ep[2]; ALHalo al[2];
#pragma unroll
    for (int g = 0; g < 2; ++g) {
      int i = (2 * pi + g) - b * 68;
      ep[g].VXT = (u16*)(ws + WS_VXT); ep[g].X0T = (u16*)(ws + WS_X0T); ep[g].cw = p.in[22]; ep[g].cb = p.in[23];
      ep[g].b = b; ep[g].tbase = 124 * i - 2; ep[g].nt = nt;
      al[g].wsb = ws; al[g].hoff = (unsigned)(WS_HA + (size_t)b * L * D * 2); al[g].t0 = ep[g].tbase;
    }
    gemm_tile2<3>(smem, al[0], al[1], W + (size_t)nt * 192 * D, D, ep[0], ep[1], p.flags);
  }
}

__device__ __forceinline__ void ln_norm(float (&v)[16]) {
  float s = 0.f;
#pragma unroll
  for (int i = 0; i < 16; ++i) s += v[i];
  const float mu = wave_sum(s) * (1.f / D);
  float q = 0.f;
#pragma unroll
  for (int i = 0; i < 16; ++i) { v[i] -= mu; q += v[i] * v[i]; }
  const float rs = rsqrtf(wave_sum(q) * (1.f / D) + LN_EPS);
#pragma unroll
  for (int i = 0; i < 16; ++i) v[i] *= rs;
}
__device__ __forceinline__ void ld8f(const float* p, float* o) {
  float4 a = *(const float4*)p, b = *(const float4*)(p + 4);
  o[0] = a.x; o[1] = a.y; o[2] = a.z; o[3] = a.w; o[4] = b.x; o[5] = b.y; o[6] = b.z; o[7] = b.w;
}
struct LnPar { float g[16], b[16]; };
__device__ __forceinline__ void ln_row(float (&v)[16], const LnPar* par, float* dstf, u16* dst16,
                                       const float* shift, const float* scale, u16* dsth) {
  const int l = threadIdx.x & 63;
  if (par) {
    ln_norm(v);
#pragma unroll
    for (int h = 0; h < 2; ++h) {
#pragma unroll
      for (int e = 0; e < 8; ++e) v[h * 8 + e] = v[h * 8 + e] * par->g[h * 8 + e] + par->b[h * 8 + e];
      if (dstf) {
        *(float4*)(dstf + h * 512 + l * 8) = make_float4(v[h * 8], v[h * 8 + 1], v[h * 8 + 2], v[h * 8 + 3]);
        *(float4*)(dstf + h * 512 + l * 8 + 4) = make_float4(v[h * 8 + 4], v[h * 8 + 5], v[h * 8 + 6], v[h * 8 + 7]);
      }
      if (dst16) *(uint4*)(dst16 + h * 512 + l * 8) = make_uint4(cvtpk(v[h * 8], v[h * 8 + 1]), cvtpk(v[h * 8 + 2], v[h * 8 + 3]), cvtpk(v[h * 8 + 4], v[h * 8 + 5]), cvtpk(v[h * 8 + 6], v[h * 8 + 7]));
    }
  }
  if (dsth) {
    ln_norm(v);
#pragma unroll
    for (int h = 0; h < 2; ++h) {
      float sc[8], sh[8]; ld8f(scale + h * 512 + l * 8, sc); ld8f(shift + h * 512 + l * 8, sh);
      float o[8];
#pragma unroll
      for (int e = 0; e < 8; ++e) o[e] = v[h * 8 + e] * (1.f + sc[e]) + sh[e];
      *(uint4*)(dsth + h * 512 + l * 8) = make_uint4(cvtpk(o[0], o[1]), cvtpk(o[2], o[3]), cvtpk(o[4], o[5]), cvtpk(o[6], o[7]));
    }
  }
}
__device__ __forceinline__ void phase_ln(const Params& p, const float* srcf, const u16* src16, const float* lg, const float* lb, float* dstf, u16* dst16,
                         int mod_layer, int shift_off, int scale_off, bool do_mod, bool with_ctx) {
  char* ws = p.ws;
  const int wg = blockIdx.x * 8 + (threadIdx.x >> 6), nw = gridDim.x * 8, l = threadIdx.x & 63;
  u16* HA = (u16*)(ws + WS_HA);
  const float* modv = (const float*)(ws + WS_MODV) + (size_t)mod_layer * 5 * NMOD;
  const int nrows = with_ctx ? M + NB * LC : M;
  LnPar par;
  if (lg) {
#pragma unroll
    for (int h = 0; h < 2; ++h) { ld8f(lg + h * 512 + l * 8, par.g + h * 8); ld8f(lb + h * 512 + l * 8, par.b + h * 8); }
  }
  auto loadrow = [&](int row, float (&v)[16]) {
    if (row < M && src16) {
#pragma unroll
      for (int h = 0; h < 2; ++h) {
        uint4 t = *(const uint4*)(src16 + (size_t)row * D + h * 512 + l * 8);
        v[h * 8] = bflo(t.x); v[h * 8 + 1] = bfhi(t.x); v[h * 8 + 2] = bflo(t.y); v[h * 8 + 3] = bfhi(t.y);
        v[h * 8 + 4] = bflo(t.z); v[h * 8 + 5] = bfhi(t.z); v[h * 8 + 6] = bflo(t.w); v[h * 8 + 7] = bfhi(t.w);
      }
    } else {
      const float* sp = (row < M) ? srcf + (size_t)row * D : p.in[2] + (size_t)(row - M) * D;
#pragma unroll
      for (int h = 0; h < 2; ++h) ld8f(sp + h * 512 + l * 8, v + h * 8);
    }
  };
  auto dorow = [&](int row, float (&v)[16]) {
    if (row < M) {
      int b = row >> 13;
      ln_row(v, lg ? &par : nullptr, dstf ? dstf + (size_t)row * D : nullptr, dst16 ? dst16 + (size_t)row * D : nullptr,
             modv + (size_t)b * NMOD + shift_off, modv + (size_t)b * NMOD + scale_off, do_mod ? HA + (size_t)row * D : nullptr);
    } else {
      ln_row(v, nullptr, nullptr, nullptr,
             modv + (size_t)4 * NMOD + shift_off, modv + (size_t)4 * NMOD + scale_off, HA + (size_t)row * D);
    }
  };
  for (int row = wg; row < nrows; row += 2 * nw) {
    float v0[16], v1[16];
    const int row1 = row + nw;
    loadrow(row, v0);
    if (row1 < nrows) loadrow(row1, v1);
    dorow(row, v0);
    if (row1 < nrows) dorow(row1, v1);
  }
}

__device__ __forceinline__ int swap23(int x) { return (x & ~12) | ((x & 4) << 1) | ((x & 8) >> 1); }
__device__ __forceinline__ void attn_unit(const Params& p, char* smem, int b, int h, int qb) {
  char* ws = p.ws;
  const int tid = threadIdx.x, w = tid >> 6, l = tid & 63, comp = w >> 2, qf = w & 3, r32 = l & 31, hh = l >> 5;
  const int wvb = __builtin_amdgcn_readfirstlane((tid >> 6) << 10);
  const int bh = b * 4 + h;
  const u16* Qg = (const u16*)(ws + WS_Q) + ((size_t)(bh * 2 + comp) * L + qb * 128 + qf * 32 + r32) * 64;
  bf16x8 qfrag[4];
#pragma unroll
  for (int s = 0; s < 4; ++s) qfrag[s] = *(const bf16x8*)(Qg + 16 * s + 8 * hh);
  const int prow = tid >> 3, pc = tid & 7;
  const unsigned koff = (unsigned)(swap23(prow) * 128 + ((pc ^ ((prow >> 1) & 7)) << 4));
  const unsigned k1base = (unsigned)(WS_K + (size_t)(bh * 2) * LK * 128) + koff;
  const unsigned k2base = k1base + (unsigned)(LK * 128);
  const unsigned vbase = (unsigned)(WS_VT + (size_t)bh * 128 * LK * 2) + (unsigned)prow * (LK * 2) + ((pc ^ ((prow >> 1) & 7)) << 4);
  auto issueT = [&](int it) {
    char* slot = smem + (it & 3) * 32768 + wvb;
    glds16u(ws, k1base + (unsigned)it * 8192u, slot);
    glds16u(ws, k2base + (unsigned)it * 8192u, slot + 8192);
    glds16u(ws, vbase + (unsigned)it * 128u, slot + 16384);
    glds16u(ws, vbase + (unsigned)it * 128u + 64u * (LK * 2), slot + 24576);
  };
  f32x16 o[4];
#pragma unroll
  for (int i = 0; i < 4; ++i)
#pragma unroll
    for (int j = 0; j < 16; ++j) o[i][j] = 0.f;
  float mrun = 0.f, lsum = 0.f;
  constexpr int NIT = LK / 64;
  constexpr float THR = 8.f;
  auto qk = [&](f32x16& s0, f32x16& s1, int it, float init) {
    const char* Kb = smem + (it & 3) * 32768 + comp * 8192;
    bf16x8 a0[4], a1[4];
#pragma unroll
    for (int s = 0; s < 4; ++s) { a0[s] = *(const bf16x8*)(Kb + swz16(r32, 2 * s + hh)); a1[s] = *(const bf16x8*)(Kb + swz16(32 + r32, 2 * s + hh)); }
#pragma unroll
    for (int j = 0; j < 16; ++j) { s0[j] = init; s1[j] = init; }
#pragma unroll
    for (int s = 0; s < 4; ++s) {
      s0 = __builtin_amdgcn_mfma_f32_32x32x16_bf16(a0[s], qfrag[s], s0, 0, 0, 0);
      s1 = __builtin_amdgcn_mfma_f32_32x32x16_bf16(a1[s], qfrag[s], s1, 0, 0, 0);
    }
  };
#define ABAR() do { __builtin_amdgcn_s_barrier(); asm volatile("" ::: "memory"); } while (0)
  bf16x8 pb[2][2];
  auto half1 = [&](f32x16& c0, f32x16& c1, f32x16& n0, f32x16& n1, int it) {
    if (comp == 1 && it + 3 < NIT) issueT(it + 3);
    float mx = c0[0];
#pragma unroll
    for (int j = 1; j < 16; ++j) mx = fmaxf(mx, c0[j]);
#pragma unroll
    for (int j = 0; j < 16; ++j) mx = fmaxf(mx, c1[j]);
    { auto rr = __builtin_amdgcn_permlane32_swap(__float_as_uint(mx), __float_as_uint(mx), false, false);
      mx = fmaxf(__uint_as_float(rr[0]), __uint_as_float(rr[1])); }
    if (__builtin_expect(__any((mx > THR) || (it == 0)), 0)) {
      const float d = (it == 0) ? mx : fmaxf(mx, 0.f);
      const float al = __builtin_amdgcn_exp2f(-d);
      mrun += d; lsum *= al;
#pragma unroll
      for (int j = 0; j < 16; ++j) { c0[j] -= d; c1[j] -= d; }
#pragma unroll
      for (int i = 0; i < 4; ++i)
#pragma unroll
        for (int j = 0; j < 16; ++j) o[i][j] *= al;
    }
    if (it + 1 < NIT) qk(n0, n1, it + 1, -mrun);
    float ps = 0.f;
#pragma unroll
    for (int j = 0; j < 16; ++j) { c0[j] = __builtin_amdgcn_exp2f(c0[j]); ps += c0[j]; }
#pragma unroll
    for (int j = 0; j < 16; ++j) { c1[j] = __builtin_amdgcn_exp2f(c1[j]); ps += c1[j]; }
    lsum += ps;
#pragma unroll
    for (int s2 = 0; s2 < 2; ++s2) {
      uint4 u = make_uint4(cvtpk(c0[8 * s2], c0[8 * s2 + 1]), cvtpk(c0[8 * s2 + 2], c0[8 * s2 + 3]), cvtpk(c0[8 * s2 + 4], c0[8 * s2 + 5]), cvtpk(c0[8 * s2 + 6], c0[8 * s2 + 7]));
      pb[0][s2] = *(bf16x8*)&u;
      uint4 u2 = make_uint4(cvtpk(c1[8 * s2], c1[8 * s2 + 1]), cvtpk(c1[8 * s2 + 2], c1[8 * s2 + 3]), cvtpk(c1[8 * s2 + 4], c1[8 * s2 + 5]), cvtpk(c1[8 * s2 + 6], c1[8 * s2 + 7]));
      pb[1][s2] = *(bf16x8*)&u2;
    }
#pragma unroll
    for (int g = 0; g < 8; ++g) { __builtin_amdgcn_sched_group_barrier(0x008, 1, 0); __builtin_amdgcn_sched_group_barrier(0x002, 12, 0); }
    if (comp == 1) {
      if (it + 3 < NIT) asm volatile("s_waitcnt vmcnt(4) lgkmcnt(0)" ::: "memory");
      else asm volatile("s_waitcnt vmcnt(0) lgkmcnt(0)" ::: "memory");
    } else asm volatile("s_waitcnt lgkmcnt(0)" ::: "memory");
    ABAR();
  };
  auto half2 = [&](int it) {
    if (comp == 0 && it + 3 < NIT) issueT(it + 3);
    const char* Vb = smem + (it & 3) * 32768 + 16384;
    bf16x8 va[4], vb2[4];
    auto rdV = [&](bf16x8 (&v)[4], int k) {
#pragma unroll
      for (int ef = 0; ef < 4; ++ef) v[ef] = *(const bf16x8*)(Vb + swz16(ef * 32 + r32, 2 * k + hh));
    };
    rdV(va, 0); rdV(vb2, 1); SB();
#pragma unroll
    for (int ef = 0; ef < 4; ++ef) o[ef] = __builtin_amdgcn_mfma_f32_32x32x16_bf16(va[ef], pb[0][0], o[ef], 0, 0, 0);
    SB(); rdV(va, 2); SB();
#pragma unroll
    for (int ef = 0; ef < 4; ++ef) o[ef] = __builtin_amdgcn_mfma_f32_32x32x16_bf16(vb2[ef], pb[0][1], o[ef], 0, 0, 0);
    SB(); rdV(vb2, 3); SB();
#pragma unroll
    for (int ef = 0; ef < 4; ++ef) o[ef] = __builtin_amdgcn_mfma_f32_32x32x16_bf16(va[ef], pb[1][0], o[ef], 0, 0, 0);
    SB();
#pragma unroll
    for (int ef = 0; ef < 4; ++ef) o[ef] = __builtin_amdgcn_mfma_f32_32x32x16_bf16(vb2[ef], pb[1][1], o[ef], 0, 0, 0);
    if (comp == 0) {
      if (it + 3 < NIT) asm volatile("s_waitcnt vmcnt(4) lgkmcnt(0)" ::: "memory");
      else asm volatile("s_waitcnt vmcnt(0) lgkmcnt(0)" ::: "memory");
    } else asm volatile("s_waitcnt lgkmcnt(0)" ::: "memory");
    ABAR();
  };
  issueT(0); issueT(1); issueT(2);
  asm volatile("s_waitcnt vmcnt(0) lgkmcnt(0)" ::: "memory");
  ABAR();
  f32x16 sa0, sa1, sb0, sb1;
  qk(sa0, sa1, 0, 0.f);
  if (comp == 1) { asm volatile("s_waitcnt lgkmcnt(0)" ::: "memory"); ABAR(); }
  for (int it = 0; it < NIT; it += 2) {
    half1(sa0, sa1, sb0, sb1, it);
    half2(it);
    half1(sb0, sb1, sa0, sa1, it + 1);
    half2(it + 1);
  }
  if (comp == 0) ABAR();
  __syncthreads();
  float ltot = lsum + swap32_f(lsum);
  float inv = 1.f / ltot;
  float* X = (float*)smem;
  if (comp == 1) {
#pragma unroll
    for (int ef = 0; ef < 4; ++ef)
#pragma unroll
      for (int j = 0; j < 16; ++j) {
        int e = ef * 32 + (j & 3) + 8 * (j >> 2) + 4 * hh;
        X[(qf * 128 + e) * 32 + r32] = o[ef][j] * inv;
      }
  }
  __syncthreads();
  if (comp == 0) {
    const float lam = *(const float*)(ws + WS_MISC);
    float ss = 0.f;
#pragma unroll
    for (int ef = 0; ef < 4; ++ef)
#pragma unroll
      for (int j = 0; j < 16; ++j) {
        int e = ef * 32 + (j & 3) + 8 * (j >> 2) + 4 * hh;
        float val = o[ef][j] * inv - lam * X[(qf * 128 + e) * 32 + r32];
        o[ef][j] = val; ss += val * val;
      }
    ss += swap32_f(ss);
    float rms = rsqrtf(ss * (1.f / 128.f) + LN_EPS) * 0.8f;
    const float* sg = p.in[20];
    u16* dst = (u16*)(ws + WS_O) + ((size_t)b * L + qb * 128 + qf * 32 + r32) * 512 + h * 128;
#pragma unroll
    for (int ef = 0; ef < 4; ++ef)
#pragma unroll
      for (int jg = 0; jg < 4; ++jg) {
        int e = ef * 32 + 8 * jg + 4 * hh;
        float4 g = *(const float4*)(sg + e);
        uint2 ov;
        ov.x = cvtpk(o[ef][4 * jg] * rms * g.x, o[ef][4 * jg + 1] * rms * g.y);
        ov.y = cvtpk(o[ef][4 * jg + 2] * rms * g.z, o[ef][4 * jg + 3] * rms * g.w);
        *(uint2*)(dst + e) = ov;
      }
  }
  __syncthreads();
}

__device__ __forceinline__ float2 cmul(float2 a, float2 b) { return make_float2(a.x * b.x - a.y * b.y, a.x * b.y + a.y * b.x); }
__device__ __forceinline__ float2 twid(float frac) {
  return make_float2(__builtin_amdgcn_cosf(frac), -__builtin_amdgcn_sinf(frac));
}
template <int N>
__device__ __forceinline__ void fft_fwd(float2* s) {
  const int tid = threadIdx.x;
  constexpr int LOGN = (N == 8192) ? 13 : 14;
  int Ns = N;
  if (LOGN & 1) {
    constexpr int H = N / 2;
    for (int j = tid; j < H; j += NTH) {
      float2 a = s[j], b = s[j + H];
      float2 wv = twid((float)j * (1.f / N));
      s[j] = make_float2(a.x + b.x, a.y + b.y);
      s[j + H] = cmul(make_float2(a.x - b.x, a.y - b.y), wv);
    }
    Ns = H;
    __syncthreads();
  }
  for (; Ns >= 4; Ns >>= 2) {
    const int q = Ns >> 2;
    const int lq = 31 - __builtin_clz(q);
    const float invNs = 1.f / (float)Ns;
#pragma unroll 2
    for (int idx = tid; idx < N / 4; idx += NTH) {
      int g = idx >> lq, j = idx & (q - 1); int base = g * Ns + j;
      float2 a0 = s[base], a1 = s[base + q], a2 = s[base + 2 * q], a3 = s[base + 3 * q];
      float2 w1 = twid((float)j * invNs), w2 = cmul(w1, w1), w3 = cmul(w2, w1);
      float2 t0 = make_float2(a0.x + a2.x, a0.y + a2.y), t1 = make_float2(a0.x - a2.x, a0.y - a2.y);
      float2 t2 = make_float2(a1.x + a3.x, a1.y + a3.y), t3 = make_float2(a1.x - a3.x, a1.y - a3.y);
      float2 b0 = make_float2(t0.x + t2.x, t0.y + t2.y);
      float2 b2 = make_float2(t0.x - t2.x, t0.y - t2.y);
      float2 b1 = make_float2(t1.x + t3.y, t1.y - t3.x);
      float2 b3 = make_float2(t1.x - t3.y, t1.y + t3.x);
      s[base] = b0; s[base + q] = cmul(b1, w1); s[base + 2 * q] = cmul(b2, w2); s[base + 3 * q] = cmul(b3, w3);
    }
    __syncthreads();
  }
}
template <int N>
__device__ __forceinline__ void fft_inv(float2* s) {
  const int tid = threadIdx.x;
  for (int Ns = 4; Ns <= N; Ns <<= 2) {
    const int q = Ns >> 2;
    const int lq = 31 - __builtin_clz(q);
    const float invNs = 1.f / (float)Ns;
#pragma unroll 2
    for (int idx = tid; idx < N / 4; idx += NTH) {
      int g = idx >> lq, j = idx & (q - 1); int base = g * Ns + j;
      float2 w1 = twid((float)j * invNs); w1.y = -w1.y;
      float2 w2 = cmul(w1, w1), w3 = cmul(w2, w1);
      float2 a0 = s[base], a1 = cmul(s[base + q], w1), a2 = cmul(s[base + 2 * q], w2), a3 = cmul(s[base + 3 * q], w3);
      float2 t0 = make_float2(a0.x + a2.x, a0.y + a2.y), t1 = make_float2(a0.x - a2.x, a0.y - a2.y);
      float2 t2 = make_float2(a1.x + a3.x, a1.y + a3.y), t3 = make_float2(a1.x - a3.x, a1.y - a3.y);
      s[base] = make_float2(t0.x + t2.x, t0.y + t2.y);
      s[base + 2 * q] = make_float2(t0.x - t2.x, t0.y - t2.y);
      s[base + q] = make_float2(t1.x - t3.y, t1.y + t3.x);
      s[base + 3 * q] = make_float2(t1.x + t3.y, t1.y - t3.x);
    }
    __syncthreads();
  }
}

__device__ __forceinline__ void fourier_unit(const Params& p, char* smem, int unit) {
  char* ws = p.ws;
  float2* s = (float2*)smem;
  const int tid = threadIdx.x;
  const unsigned* src = (const unsigned*)(ws + WS_FZ) + (size_t)unit * L;
  for (int t = tid * 4; t < L; t += NTH * 4) {
    uint4 v = *(const uint4*)(src + t);
    s[t] = make_float2(bflo(v.x), bfhi(v.x)); s[t + 1] = make_float2(bflo(v.y), bfhi(v.y));
    s[t + 2] = make_float2(bflo(v.z), bfhi(v.z)); s[t + 3] = make_float2(bflo(v.w), bfhi(v.w));
  }
  __syncthreads();
  fft_fwd<8192>(s);
  u16* dst = (u16*)(ws + WS_YT) + (size_t)unit * L;
  for (int k0 = tid * 2; k0 < L; k0 += NTH * 2) {
    float v[2];
#pragma unroll
    for (int i = 0; i < 2; ++i) {
      int k = k0 + i; int m1 = k & 1; int k1 = k >> 1;
      int pp = (m1 << 12) | ((k1 & 3) << 10) | (((k1 >> 2) & 3) << 8) | (((k1 >> 4) & 3) << 6) | (((k1 >> 6) & 3) << 4) | (((k1 >> 8) & 3) << 2) | ((k1 >> 10) & 3);
      v[i] = s[pp].x * (1.f / 1024.f);
    }
    *(unsigned*)(dst + k0) = cvtpk(v[0], v[1]);
  }
  __syncthreads();
}

__device__ __forceinline__ void phase_attn_fourier(const Params& p, char* smem) {
  if (gridDim.x == 256) {
    const int xcd = blockIdx.x & 7, j = blockIdx.x >> 3;
    for (int i = 0; i < 4; ++i) {
      int local = j + 32 * i; int pair = 2 * xcd + (local >> 6), qb = local & 63;
      attn_unit(p, smem, pair >> 2, pair & 3, qb);
    }
  } else {
    for (int u = blockIdx.x; u < 1024; u += gridDim.x) attn_unit(p, smem, u >> 8, (u >> 6) & 3, u & 63);
  }
  for (int u = blockIdx.x; u < NB * 512; u += gridDim.x) fourier_unit(p, smem, u);
}

__device__ __forceinline__ void phase_hyena_fft(const Params& p, char* smem) {
  char* ws = p.ws;
  float2* s = (float2*)smem;
  float* red = (float*)(smem + 131072);
  const int tid = threadIdx.x;
  constexpr int N = 16384;
  const float* HT = (const float*)(ws + WS_HT);
  const u16* VXT = (const u16*)(ws + WS_VXT);
  const u16* X0T = (const u16*)(ws + WS_X0T);
  u16* GT = (u16*)(ws + WS_GT);
  for (int c = blockIdx.x; c < 1024; c += gridDim.x) {
    const float* hf = HT + (size_t)c * L;
    const float* hb = HT + (size_t)(1024 + c) * L;
    float l1 = 0.f;
    for (int n = tid; n < N; n += NTH) {
      float v = (n < L) ? hf[n] : ((n == L) ? 0.f : hb[N - n]);
      s[n] = make_float2(v, 0.f); l1 += fabsf(v);
    }
    l1 = wave_sum(l1);
    if ((tid & 63) == 0) red[tid >> 6] = l1;
    __syncthreads();
    float tot = 0.f;
#pragma unroll
    for (int i = 0; i < 8; ++i) tot += red[i];
    fft_fwd<N>(s);
    const float scale = 1.f / (tot * (float)N);
    float2* kspec = (float2*)(ws + WS_KSPEC) + (size_t)blockIdx.x * N;
#pragma unroll 4
    for (int i = 0; i < 32; ++i) { float2 v = s[tid + NTH * i]; kspec[tid + NTH * i] = make_float2(v.x * scale, v.y * scale); }
    __syncthreads();
    const float dsk = p.in[32][c];
#pragma unroll 1
    for (int pair = 0; pair < 2; ++pair) {
      const u16* v0 = VXT + ((size_t)(2 * pair) * 1024 + c) * L;
      const u16* v1 = VXT + ((size_t)(2 * pair + 1) * 1024 + c) * L;
      for (int t = tid * 8; t < L; t += NTH * 8) {
        uint4 a = *(const uint4*)(v0 + t), bq = *(const uint4*)(v1 + t);
        s[t] = make_float2(bflo(a.x), bflo(bq.x)); s[t + 1] = make_float2(bfhi(a.x), bfhi(bq.x));
        s[t + 2] = make_float2(bflo(a.y), bflo(bq.y)); s[t + 3] = make_float2(bfhi(a.y), bfhi(bq.y));
        s[t + 4] = make_float2(bflo(a.z), bflo(bq.z)); s[t + 5] = make_float2(bfhi(a.z), bfhi(bq.z));
        s[t + 6] = make_float2(bflo(a.w), bflo(bq.w)); s[t + 7] = make_float2(bfhi(a.w), bfhi(bq.w));
      }
      for (int t = L + tid; t < N; t += NTH) s[t] = make_float2(0.f, 0.f);
      __syncthreads();
      fft_fwd<N>(s);
#pragma unroll 4
      for (int i = 0; i < 32; ++i) { int pp = tid + NTH * i; s[pp] = cmul(s[pp], kspec[pp]); }
      __syncthreads();
      fft_inv<N>(s);
      const u16* x0a = X0T + ((size_t)(2 * pair) * 1024 + c) * L;
      const u16* x0b = X0T + ((size_t)(2 * pair + 1) * 1024 + c) * L;
      u16* g0 = GT + ((size_t)(2 * pair) * 1024 + c) * L;
      u16* g1 = GT + ((size_t)(2 * pair + 1) * 1024 + c) * L;
      for (int t = tid * 2; t < L; t += NTH * 2) {
        unsigned va = *(const unsigned*)(v0 + t), vb = *(const unsigned*)(v1 + t);
        unsigned xa = *(const unsigned*)(x0a + t), xb = *(const unsigned*)(x0b + t);
        float2 y0 = s[t], y1 = s[t + 1];
        *(unsigned*)(g0 + t) = cvtpk((y0.x + bflo(va) * dsk) * bflo(xa), (y1.x + bfhi(va) * dsk) * bfhi(xa));
        *(unsigned*)(g1 + t) = cvtpk((y0.y + bflo(vb) * dsk) * bflo(xb), (y1.y + bfhi(vb) * dsk) * bfhi(xb));
      }
      __syncthreads();
    }
  }
}

template <int MAP>
__device__ __forceinline__ int orig_col(int n) {
  if (MAP == 0) return n;
  if (MAP == 1) { int f = (n >> 4) & 1; int ch = (n >> 8) * 128 + ((n >> 5) & 7) * 16 + (n & 15); return f * FF + ch; }
  { int nt = n / 192, rem = n - nt * 192; int wv = rem / 48, r2 = rem - wv * 48; int f = r2 >> 4; int ch = nt * 64 + wv * 16 + (r2 & 15); return f * 1024 + ch; }
}
template <int MAP>
__device__ __forceinline__ void transpose_tile(const float* W, int ldw, u16* Wt, int K, int k0, int n0, float* tl) {
  const int tid = threadIdx.x;
#pragma unroll
  for (int i = 0; i < 8; ++i) {
    int idx = tid + NTH * i; int kk = idx >> 6, nn = idx & 63;
    tl[nn * 65 + kk] = W[(size_t)(k0 + kk) * ldw + orig_col<MAP>(n0 + nn)];
  }
  __syncthreads();
#pragma unroll
  for (int i = 0; i < 8; ++i) {
    int idx = tid + NTH * i; int nn = idx >> 6, kk = idx & 63;
    Wt[(size_t)(n0 + nn) * K + k0 + kk] = f2bf(tl[nn * 65 + kk]);
  }
  __syncthreads();
}

__device__ __forceinline__ void phase_prep(const Params& p, char* smem) {
  char* ws = p.ws;
  const int tid = threadIdx.x;
  float* tl = (float*)smem;
  constexpr int T_W1 = 16 * 24, T_W2 = 256, T_W3 = 16 * 88, T_W4 = 44 * 16, T_W5 = 16 * 48, T_W6 = 256;
  constexpr int O_W1 = 0, O_W2 = O_W1 + T_W1, O_W3 = O_W2 + T_W2, O_W4 = O_W3 + 2 * T_W3, O_W5 = O_W4 + 2 * T_W4, O_W6 = O_W5 + T_W5;
  constexpr int O_FOLD = O_W6 + T_W6, O_MOD = O_FOLD + 256, O_HY = O_MOD + 192, O_MISC = O_HY + 256, O_END = O_MISC + 1;
  for (int item = blockIdx.x; item < O_END; item += gridDim.x) {
    if (item < O_W2) { int j = item - O_W1; transpose_tile<0>(p.in[14], 2048, (u16*)(ws + WS_W1T), 1024, (j & 15) * 64, (j >> 4) * 64, tl); }
    else if (item < O_W3) { int j = item - O_W2; transpose_tile<0>(p.in[15], 1024, (u16*)(ws + WS_W2T), 1024, (j & 15) * 64, (j >> 4) * 64, tl); }
    else if (item < O_W4) { int j = item - O_W3; int layer = j / T_W3; j -= layer * T_W3;
      transpose_tile<1>(p.in[10] + (size_t)layer * 1024 * 5632, 5632, (u16*)(ws + WS_W3T) + (size_t)layer * 5632 * 1024, 1024, (j & 15) * 64, (j >> 4) * 64, tl); }
    else if (item < O_W5) { int j = item - O_W4; int layer = j / T_W4; j -= layer * T_W4;
      transpose_tile<0>(p.in[13] + (size_t)layer * 2816 * 1024, 1024, (u16*)(ws + WS_W4T) + (size_t)layer * 1024 * 2816, 2816, (j % 44) * 64, (j / 44) * 64, tl); }
    else if (item < O_W6) { int j = item - O_W5; transpose_tile<2>(p.in[21], 3072, (u16*)(ws + WS_W5T), 1024, (j & 15) * 64, (j >> 4) * 64, tl); }
    else if (item < O_FOLD) { int j = item - O_W6; transpose_tile<0>(p.in[33], 1024, (u16*)(ws + WS_W6T), 1024, (j & 15) * 64, (j >> 4) * 64, tl); }
    else if (item < O_MOD) {
      int j = item - O_FOLD; int g = j >> 6, k0 = (j & 63) * 16;
      float* wl = tl;
      float* cs = tl + 2048;
      for (int i = tid; i < 2048; i += NTH) { int kk = i >> 7, cc = i & 127; wl[i] = p.in[14][(size_t)(k0 + kk) * 2048 + 1536 + g * 128 + cc]; }
      if (tid < 128) { float sv, cv; sincospif((float)tid * (1.f / 64.f), &sv, &cv); cs[tid] = cv; cs[128 + tid] = sv; }
      __syncthreads();
      {
        int m = tid & 127, fsel = (tid >> 7) & 1, kh = tid >> 8;
        float accv[8];
#pragma unroll
        for (int i = 0; i < 8; ++i) accv[i] = 0.f;
        for (int cc = 0; cc < 128; ++cc) {
          float tw = fsel ? -cs[128 + ((m * cc) & 127)] : cs[(m * cc) & 127];
#pragma unroll
          for (int i = 0; i < 8; ++i) accv[i] += wl[(kh * 8 + i) * 128 + cc] * tw;
        }
        int ch = g * 128 + m;
        int nprime = 1536 + (ch >> 7) * 256 + ((ch >> 4) & 7) * 32 + fsel * 16 + (ch & 15);
        u16* dst = (u16*)(ws + WS_W1T) + (size_t)nprime * 1024 + k0 + kh * 8;
        uint4 ov; ov.x = cvtpk(accv[0], accv[1]); ov.y = cvtpk(accv[2], accv[3]); ov.z = cvtpk(accv[4], accv[5]); ov.w = cvtpk(accv[6], accv[7]);
        *(uint4*)dst = ov;
      }
      __syncthreads();
    }
    else if (item < O_HY) {
      int j = item - O_MOD; int layer = j / 96, n0 = (j % 96) * 64;
      float* sv = tl;
      float* red = tl + 5 * 1024;
      for (int i = tid; i < 5 * 1024; i += NTH) {
        int v = i >> 10, k = i & 1023;
        float x = (v < 4) ? p.in[1][v * 1024 + k] : p.in[3][k];
        sv[i] = x / (1.f + __expf(-x));
      }
      __syncthreads();
      int kg = tid >> 6, nn = tid & 63;
      const float* Wm = p.in[4] + (size_t)layer * 1024 * NMOD + n0 + nn;
      float a0 = 0, a1 = 0, a2 = 0, a3 = 0, a4 = 0;
      for (int k0 = kg; k0 < 1024; k0 += 128) {
        float wv[16];
#pragma unroll
        for (int u = 0; u < 16; ++u) wv[u] = Wm[(size_t)(k0 + 8 * u) * NMOD];
#pragma unroll
        for (int u = 0; u < 16; ++u) {
          const int k = k0 + 8 * u;
          a0 += sv[k] * wv[u]; a1 += sv[1024 + k] * wv[u]; a2 += sv[2048 + k] * wv[u]; a3 += sv[3072 + k] * wv[u]; a4 += sv[4096 + k] * wv[u];
        }
      }
      red[(kg * 5 + 0) * 64 + nn] = a0; red[(kg * 5 + 1) * 64 + nn] = a1; red[(kg * 5 + 2) * 64 + nn] = a2; red[(kg * 5 + 3) * 64 + nn] = a3; red[(kg * 5 + 4) * 64 + nn] = a4;
      __syncthreads();
      if (tid < 320) {
        int v = tid >> 6; float sum = 0.f;
#pragma unroll
        for (int g = 0; g < 8; ++g) sum += red[(g * 5 + v) * 64 + nn];
        ((float*)(ws + WS_MODV))[((size_t)layer * 5 + v) * NMOD + n0 + nn] = sum + p.in[5][(size_t)layer * NMOD + n0 + nn];
      }
      __syncthreads();
    }
    else if (item < O_MISC) {
      int j = item - O_HY; int tb = j * 32;
      float* z = tl;
      float* h1 = tl + 32 * 36;
      float* h2 = h1 + 32 * 64;
      float* h3 = h2 + 32 * 64;
      const float* w1 = p.in[24]; const float* b1 = p.in[25]; const float* w2 = p.in[26]; const float* b2 = p.in[27];
      const float* w3 = p.in[28]; const float* b3 = p.in[29]; const float* fr = p.in[30]; const float* w4 = p.in[31];
      for (int i = tid; i < 32 * 33; i += NTH) {
        int tt = i / 33, e = i - tt * 33; int t = tb + tt; float val;
        if (e == 0) val = (float)t / (float)(L - 1);
        else {
          int jb = (e - 1) & 15;
          double fb = 1e-4 + (double)jb * ((15.0 - 1e-4) / 15.0);
          double rev = fb * (double)t / (double)L; rev -= floor(rev);
          float sn, cn; sincospif((float)(2.0 * rev), &sn, &cn);
          val = (e <= 16) ? cn : -sn;
        }
        z[tt * 36 + e] = val;
      }
      __syncthreads();
      for (int i = tid; i < 32 * 64; i += NTH) {
        int tt = i >> 6, o = i & 63; float a = b1[o];
        for (int e = 0; e < 33; ++e) a += z[tt * 36 + e] * w1[e * 64 + o];
        h1[tt * 64 + o] = sinf(fr[o] * a);
      }
      __syncthreads();
      for (int i = tid; i < 32 * 64; i += NTH) {
        int tt = i >> 6, o = i & 63; float a = b2[o];
        for (int e = 0; e < 64; ++e) a += h1[tt * 64 + e] * w2[e * 64 + o];
        h2[tt * 64 + o] = sinf(fr[o] * a);
      }
      __syncthreads();
      for (int i = tid; i < 32 * 64; i += NTH) {
        int tt = i >> 6, o = i & 63; float a = b3[o];
        for (int e = 0; e < 64; ++e) a += h2[tt * 64 + e] * w3[e * 64 + o];
        h3[tt * 64 + o] = sinf(fr[o] * a);
      }
      __syncthreads();
      const float min_decay = -3.0701134573253945f, max_decay = -15.350567286626972f;
      for (int nb = 0; nb < 2; ++nb) {
        const int n0 = nb * 2 * NTH + tid, n1 = n0 + NTH;
        float acc0[32], acc1[32];
#pragma unroll
        for (int tt = 0; tt < 32; ++tt) { acc0[tt] = 0.f; acc1[tt] = 0.f; }
        for (int e4 = 0; e4 < 16; ++e4) {
          const float* wr = w4 + (size_t)(4 * e4) * 2048;
          float wa0 = wr[n0], wb0 = wr[2048 + n0], wc0 = wr[4096 + n0], wd0 = wr[6144 + n0];
          float wa1 = wr[n1], wb1 = wr[2048 + n1], wc1 = wr[4096 + n1], wd1 = wr[6144 + n1];
#pragma unroll
          for (int tt = 0; tt < 32; ++tt) {
            float4 hv = *(const float4*)(h3 + tt * 64 + 4 * e4);
            acc0[tt] += hv.x * wa0 + hv.y * wb0 + hv.z * wc0 + hv.w * wd0;
            acc1[tt] += hv.x * wa1 + hv.y * wb1 + hv.z * wc1 + hv.w * wd1;
          }
        }
#pragma unroll
        for (int half = 0; half < 2; ++half) {
          const int n = half ? n1 : n0;
          int cc = n & 1023;
          float delta = fabsf(min_decay + (float)cc * ((max_decay - min_decay) / 1023.f));
          float* dst = (float*)(ws + WS_HT) + (size_t)n * L + tb;
#pragma unroll
          for (int t4 = 0; t4 < 8; ++t4) {
            float4 ov;
            ov.x = (half ? acc1[4 * t4] : acc0[4 * t4]) * __expf(-delta * (float)(tb + 4 * t4) / (float)(L - 1));
            ov.y = (half ? acc1[4 * t4 + 1] : acc0[4 * t4 + 1]) * __expf(-delta * (float)(tb + 4 * t4 + 1) / (float)(L - 1));
            ov.z = (half ? acc1[4 * t4 + 2] : acc0[4 * t4 + 2]) * __expf(-delta * (float)(tb + 4 * t4 + 2) / (float)(L - 1));
            ov.w = (half ? acc1[4 * t4 + 3] : acc0[4 * t4 + 3]) * __expf(-delta * (float)(tb + 4 * t4 + 3) / (float)(L - 1));
            *(float4*)(dst + 4 * t4) = ov;
          }
        }
      }
      __syncthreads();
    }
    else {
      ((unsigned*)(ws + WS_ZROW))[tid] = 0u;
      if (tid == 0) ((float2*)(ws + WS_ROPE))[2048] = make_float2(1.f, 0.f);
      for (int i = tid; i < 128 * 16; i += NTH) {
        int pos = i >> 4, jj = i & 15;
        float inv = exp2f(-(float)jj * (13.287712379549449f / 16.f));
        float sn, cn; sincosf((float)pos * inv, &sn, &cn);
        ((float2*)(ws + WS_ROPE))[i] = make_float2(cn, sn);
      }
      if (tid < 64) {
        float a = p.in[16][tid] * p.in[17][tid], bq = p.in[18][tid] * p.in[19][tid];
        a = wave_sum(a); bq = wave_sum(bq);
        if (tid == 0) *(float*)(ws + WS_MISC) = expf(a) - expf(bq) + 0.2f;
      }
      __syncthreads();
    }
  }
}

__device__ __forceinline__ void grid_bar(unsigned* ctr) {
  asm volatile("s_waitcnt vmcnt(0) lgkmcnt(0)" ::: "memory");
  __syncthreads();
  if (threadIdx.x == 0) {
    __threadfence();
    __hip_atomic_fetch_add(ctr, 1u, __ATOMIC_RELAXED, __HIP_MEMORY_SCOPE_AGENT);
    while (__hip_atomic_load(ctr, __ATOMIC_RELAXED, __HIP_MEMORY_SCOPE_AGENT) < gridDim.x) __builtin_amdgcn_s_sleep(2);
    __threadfence();
  }
  __syncthreads();
}

__global__ void __launch_bounds__(NTH) fwd_kernel(Params p) {
  extern __shared__ __attribute__((aligned(16))) char smem[];
  cg::grid_group grid = cg::this_grid();
  char* ws = p.ws;
  u16* RX = (u16*)(ws + WS_RX);
#ifdef ONLYP
#define PH(n) if ((n) == ONLYP)
#else
#define PH(n) if (p.ph_lo <= (n) && (n) < p.ph_hi)
#endif
#define SYNC(n) if (p.ph_lo <= (n) && (n) + 1 < p.ph_hi) grid_bar((unsigned*)(ws + WS_BAR) + 64 * (n));
  if (p.ph_hi > 1000) grid.sync();
  PH(0) phase_prep(p, smem);
  SYNC(0)
  PH(1) phase_ln(p, p.in[0], nullptr, nullptr, nullptr, nullptr, nullptr, 0, 0, 1024, true, true);
  SYNC(1)
  PH(2) phase_gemm1(p, smem);
  SYNC(2)
  PH(3) phase_attn_fourier(p, smem);
  SYNC(3)
  PH(4) phase_gemm_res<1>(p, smem, nullptr, 1024, (const u16*)(ws + WS_W2T), p.in[0], nullptr, RX, 0, 2048);
  SYNC(4)
  PH(5) phase_ln(p, nullptr, RX, p.in[6], p.in[7], nullptr, RX, 0, 3072, 4096, true, false);
  SYNC(5)
  PH(6) phase_gemm_ffn_in(p, smem, 0);
  SYNC(6)
  PH(7) phase_gemm_res<0>(p, smem, (const u16*)(ws + WS_H), FF, (const u16*)(ws + WS_W4T), nullptr, RX, RX, 0, 5120);
  SYNC(7)
  PH(8) phase_ln(p, nullptr, RX, p.in[8], p.in[9], nullptr, RX, 1, 0, 1024, true, false);
  SYNC(8)
  PH(9) phase_gemm_hy_in(p, smem);
  SYNC(9)
  PH(10) phase_hyena_fft(p, smem);
  SYNC(10)
  PH(11) phase_gemm_res<2>(p, smem, (const u16*)(ws + WS_GT), 1024, (const u16*)(ws + WS_W6T), nullptr, RX, RX, 1, 2048);
  SYNC(11)
  PH(12) phase_ln(p, nullptr, RX, p.in[6] + D, p.in[7] + D, nullptr, RX, 1, 3072, 4096, true, false);
  SYNC(12)
  PH(13) phase_gemm_ffn_in(p, smem, 1);
  SYNC(13)
  PH(14) phase_gemm_res<0>(p, smem, (const u16*)(ws + WS_H), FF, (const u16*)(ws + WS_W4T) + (size_t)1024 * FF, nullptr, RX, RX, 1, 5120);
  SYNC(14)
  PH(15) phase_ln(p, nullptr, RX, p.in[8] + D, p.in[9] + D, p.out, nullptr, 1, 0, 0, false, false);
#undef PH
#undef SYNC
}

extern "C" void kernel_launch(void* const* d_in, const int* in_sizes, int n_in, void* d_out, int out_size, void* d_ws, size_t ws_size, hipStream_t stream) {
  static int grid_blocks = 0;
  if (grid_blocks == 0) {
    if (n_in != 34 || ws_size < WS_END) { fprintf(stderr, "kernel_launch: bad n_in %d or ws %zu < %zu\n", n_in, ws_size, (size_t)WS_END); grid_blocks = -1; return; }
    int dev = 0, cus = 0, per_cu = 0;
    hipGetDevice(&dev);
    hipDeviceGetAttribute(&cus, hipDeviceAttributeMultiprocessorCount, dev);
    if (hipFuncSetAttribute((const void*)fwd_kernel, hipFuncAttributeMaxDynamicSharedMemorySize, LDS_BYTES) != hipSuccess) { fprintf(stderr, "hipFuncSetAttribute failed\n"); grid_blocks = -1; return; }
    hipOccupancyMaxActiveBlocksPerMultiprocessor(&per_cu, (const void*)fwd_kernel, NTH, LDS_BYTES);
    if (per_cu < 1) { fprintf(stderr, "occupancy 0\n"); grid_blocks = -1; return; }
    grid_blocks = cus * 1;
  }
  if (grid_blocks < 0) return;
  Params p{};
  for (int i = 0; i < 34; ++i) p.in[i] = (const float*)d_in[i];
  p.out = (float*)d_out; p.ws = (char*)d_ws; p.ph_lo = 0; p.ph_hi = 16;
  if (hipMemsetAsync((char*)d_ws + WS_BAR, 0, 16 * 256, stream) != hipSuccess) { fprintf(stderr, "memset failed\n"); return; }
  void* args[] = {&p};
  hipError_t e = hipLaunchCooperativeKernel((const void*)fwd_kernel, dim3(grid_blocks), dim3(NTH), args, LDS_BYTES, stream);
  if (e != hipSuccess) fprintf(stderr, "cooperative launch failed: %s (grid %d)\n", hipGetErrorString(e), grid_blocks);
#if DUP_PHASE >= 0
  {
    Params q = p; q.ph_lo = DUP_PHASE; q.ph_hi = DUP_PHASE + 1; q.flags = DUP_FLAGS;
    hipLaunchKernelGGL(fwd_kernel, dim3(grid_blocks), dim3(NTH), LDS_BYTES, stream, q);
  }
#endif
}
```

```cpp
#include <hip/hip_runtime.h>
#include <hip/hip_bf16.h>
#include <hip/hip_cooperative_groups.h>
#include <cstdio>
namespace cg = cooperative_groups;

typedef unsigned short u16;
typedef __attribute__((ext_vector_type(8))) short bf16x8;
typedef __attribute__((ext_vector_type(4))) float f32x4;
typedef __attribute__((ext_vector_type(16))) float f32x16;

constexpr int D = 1024, NB = 4, L = 8192, LC = 256, LK = L + LC, M = NB * L;
constexpr int FF = 2816, NMOD = 6144;
constexpr int NTH = 512;
constexpr float ALPHA = 1.4142135623730951f;
constexpr float LN_EPS = 1e-5f;
constexpr float QSCALE = 0.125f * 1.4426950408889634f;

constexpr size_t AL256(size_t x) { return (x + 255) & ~(size_t)255; }
constexpr size_t WS_W1T = 0;
constexpr size_t WS_W2T = WS_W1T + (size_t)2560 * 1024 * 2;
constexpr size_t WS_W3T = WS_W2T + (size_t)1024 * 1024 * 2;
constexpr size_t WS_W4T = WS_W3T + (size_t)2 * 5632 * 1024 * 2;
constexpr size_t WS_W5T = WS_W4T + (size_t)2 * 1024 * 2816 * 2;
constexpr size_t WS_W6T = WS_W5T + (size_t)3072 * 1024 * 2;
constexpr size_t WS_MODV = WS_W6T + (size_t)1024 * 1024 * 2;
constexpr size_t WS_MISC = WS_MODV + AL256((size_t)2 * 5 * NMOD * 4);
constexpr size_t WS_BAR = WS_MISC + 256;
constexpr size_t WS_ZROW = WS_BAR + 16 * 256;
constexpr size_t WS_ROPE = WS_ZROW + 2048;
constexpr size_t WS_HT = WS_ROPE + (size_t)128 * 16 * 8 + 256;
constexpr size_t WS_HA = WS_HT + (size_t)2 * 1024 * 8192 * 4;
constexpr size_t WS_RX = WS_HA + (size_t)33792 * 1024 * 2;
constexpr size_t WS_E = WS_RX + (size_t)M * 1024 * 4;
constexpr size_t WS_Q = WS_E;
constexpr size_t WS_K = WS_Q + (size_t)NB * 4 * 2 * L * 64 * 2;
constexpr size_t WS_VT = WS_K + (size_t)NB * 4 * 2 * LK * 64 * 2;
constexpr size_t WS_FZ = WS_VT + (size_t)NB * 4 * 128 * LK * 2;
constexpr size_t WS_H = WS_E;
constexpr size_t WS_VXT = WS_E;
constexpr size_t WS_X0T = WS_VXT + (size_t)NB * 1024 * L * 2;
constexpr size_t WS_KSPEC = WS_X0T + (size_t)NB * 1024 * L * 2;
constexpr size_t WS_END = WS_E + (size_t)M * FF * 2;
static_assert(WS_KSPEC + (size_t)256 * 16384 * 8 <= WS_END, "kspec fits");
constexpr size_t WS_O = WS_HA;
constexpr size_t WS_YT = WS_HA + (size_t)M * 512 * 2;
constexpr size_t WS_GT = WS_HA;

#ifndef DUP_PHASE
#define DUP_PHASE -1
#endif
#ifndef DUP_FLAGS
#define DUP_FLAGS 0
#endif
constexpr int LDS_BYTES = 131072 + 256;

struct Params {
  const float* in[34];
  float* out;
  char* ws;
  int ph_lo, ph_hi, flags, pad_;
};

__device__ __forceinline__ unsigned cvtpk(float lo, float hi) {
  unsigned r; asm volatile("v_cvt_pk_bf16_f32 %0, %1, %2" : "=v"(r) : "v"(lo), "v"(hi)); return r;
}
__device__ __forceinline__ u16 f2bf(float f) { return (u16)(cvtpk(f, 0.f) & 0xffffu); }
__device__ __forceinline__ float bf2f(unsigned h) { return __uint_as_float(h << 16); }
__device__ __forceinline__ float bflo(unsigned v) { return __uint_as_float(v << 16); }
__device__ __forceinline__ float bfhi(unsigned v) { return __uint_as_float(v & 0xffff0000u); }
__device__ __forceinline__ float wave_sum(float v) {
#pragma unroll
  for (int o = 32; o >= 1; o >>= 1) v += __shfl_xor(v, o);
  return v;
}
__device__ __forceinline__ float swap32_f(float v) {
  return __shfl_xor(v, 32);
}
__device__ __forceinline__ int swz16(int row, int c) { return row * 128 + ((c ^ ((row >> 1) & 7)) << 4); }

__device__ __forceinline__ void glds16(const u16* g, char* lds_wave_base) {
  __builtin_amdgcn_global_load_lds((const unsigned*)g, (__attribute__((address_space(3))) unsigned*)lds_wave_base, 16, 0, 0);
}
__device__ __forceinline__ void glds16u(const char* ubase, unsigned voff, char* lds_wave_base) {
  __builtin_amdgcn_global_load_lds((const unsigned*)(ubase + voff), (__attribute__((address_space(3))) unsigned*)lds_wave_base, 16, 0, 0);
}
struct ALPlain {
  const u16* base; int lda;
  __device__ __forceinline__ void issue(int kt, char* Ab) {
    const int tid = threadIdx.x; const int c = (tid & 7) ^ ((tid >> 4) & 7);
    const int wvb = __builtin_amdgcn_readfirstlane((tid >> 6) << 10);
    const unsigned voff = ((unsigned)(tid >> 3) * lda + c * 8) * 2;
#pragma unroll
    for (int i = 0; i < 2; ++i) glds16u((const char*)(base + (size_t)(64 * i) * lda + kt * 64), voff, Ab + wvb + i * 8192);
  }
  __device__ __forceinline__ void commit(char* Ab) {}
};
struct ALHalo {
  const char* wsb; unsigned hoff  ; int t0;
  __device__ __forceinline__ void issue(int kt, char* Ab) {
    const int tid = threadIdx.x; const int c = (tid & 7) ^ ((tid >> 4) & 7);
    const int wvb = __builtin_amdgcn_readfirstlane((tid >> 6) << 10);
#pragma unroll
    for (int i = 0; i < 2; ++i) {
      int row = (tid >> 3) + 64 * i; int t = t0 + row;
      unsigned off = (t >= 0 && t < L) ? hoff + ((unsigned)t * D + kt * 64 + c * 8) * 2 : (unsigned)WS_ZROW + c * 16;
      glds16u(wsb, off, Ab + wvb + i * 8192);
    }
  }
  __device__ __forceinline__ void commit(char* Ab) {}
};
__device__ __forceinline__ void trans_load(const u16* src  , uint2 (&r)[4]) {
  const int tid = threadIdx.x, kq = tid >> 5, mq = tid & 31;
#pragma unroll
  for (int i = 0; i < 4; ++i) r[i] = *(const uint2*)(src + (size_t)(4 * kq + i) * L + 4 * mq);
}
__device__ __forceinline__ void trans_store(char* Ab, const uint2 (&r)[4]) {
  const int tid = threadIdx.x, kq = tid >> 5, mq = tid & 31;
  uint2 o[4];
  o[0].x = (r[0].x & 0xffffu) | (r[1].x << 16); o[0].y = (r[2].x & 0xffffu) | (r[3].x << 16);
  o[1].x = (r[0].x >> 16) | (r[1].x & 0xffff0000u); o[1].y = (r[2].x >> 16) | (r[3].x & 0xffff0000u);
  o[2].x = (r[0].y & 0xffffu) | (r[1].y << 16); o[2].y = (r[2].y & 0xffffu) | (r[3].y << 16);
  o[3].x = (r[0].y >> 16) | (r[1].y & 0xffff0000u); o[3].y = (r[2].y >> 16) | (r[3].y & 0xffff0000u);
#pragma unroll
  for (int j = 0; j < 4; ++j) { int row = 4 * mq + j; *(uint2*)(Ab + swz16(row, kq >> 1) + (kq & 1) * 8) = o[j]; }
}
struct ALTrans {
  const u16* base; uint2 r[4];
  __device__ __forceinline__ void issue(int kt, char* Ab) { trans_load(base + (size_t)kt * 64 * L, r); }
  __device__ __forceinline__ void commit(char* Ab) { trans_store(Ab, r); }
};
struct ALCat {
  const u16* obase; const u16* ybase; uint4 r[2]; int last;
  __device__ __forceinline__ void issue(int kt, char* Ab) {
    last = kt;
    const int tid = threadIdx.x;
    if (kt < 8) {
#pragma unroll
      for (int i = 0; i < 2; ++i) { int row = (tid >> 3) + 64 * i; r[i] = *(const uint4*)(obase + (size_t)row * 512 + kt * 64 + (tid & 7) * 8); }
    } else {
      const int kq = tid >> 5, mq = tid & 31;
      const u16* src = ybase + (size_t)(kt - 8) * 64 * L + (size_t)(4 * kq) * L + 4 * mq;
      uint2 a = *(const uint2*)(src), b = *(const uint2*)(src + L), c = *(const uint2*)(src + 2 * L), d = *(const uint2*)(src + 3 * L);
      r[0] = make_uint4(a.x, a.y, b.x, b.y); r[1] = make_uint4(c.x, c.y, d.x, d.y);
    }
  }
  __device__ __forceinline__ void commit(char* Ab) {
    const int tid = threadIdx.x;
    if (last < 8) {
#pragma unroll
      for (int i = 0; i < 2; ++i) { int row = (tid >> 3) + 64 * i; *(uint4*)(Ab + swz16(row, tid & 7)) = r[i]; }
    } else {
      uint2 q[4] = {make_uint2(r[0].x, r[0].y), make_uint2(r[0].z, r[0].w), make_uint2(r[1].x, r[1].y), make_uint2(r[1].z, r[1].w)};
      trans_store(Ab, q);
    }
  }
};

#define SB() __builtin_amdgcn_sched_barrier(0)
template <int NF, class AL, class EP>
__device__ __forceinline__ void gemm_tile(char* smem, AL& al, const u16* __restrict__ Bt, int K, EP& ep) {
  constexpr int ASZ = 16384, BSZ = 16384 * NF, STG = ASZ + BSZ;
  const int tid = threadIdx.x, w = tid >> 6, l = tid & 63, fr = l & 15, fq = l >> 4;
  f32x4 acc[8][NF];
#pragma unroll
  for (int i = 0; i < 8; ++i)
#pragma unroll
    for (int j = 0; j < NF; ++j) acc[i][j] = f32x4{0.f, 0.f, 0.f, 0.f};
  const int KT = K >> 6;
  const int wvb = __builtin_amdgcn_readfirstlane((tid >> 6) << 10);
  const unsigned bvoff = ((unsigned)(tid >> 3) * K + ((tid & 7) ^ ((tid >> 4) & 7)) * 8) * 2;
  auto issueB = [&](int kt, char* Bb) {
#pragma unroll
    for (int i = 0; i < 2 * NF; ++i) glds16u((const char*)(Bt + (size_t)(64 * i) * K + kt * 64), bvoff, Bb + wvb + i * 8192);
  };
  bf16x8 A0[4], A1[4], B0[NF], B1[NF];
  auto rdA = [&](bf16x8 (&a)[4], const char* buf, int ks, int mh) {
#pragma unroll
    for (int mf = 0; mf < 4; ++mf) a[mf] = *(const bf16x8*)(buf + swz16((mh * 4 + mf) * 16 + fr, ks * 4 + fq));
  };
  auto rdB = [&](bf16x8 (&b)[NF], const char* buf, int ks) {
#pragma unroll
    for (int nf = 0; nf < NF; ++nf) b[nf] = *(const bf16x8*)(buf + ASZ + swz16(w * 16 * NF + nf * 16 + fr, ks * 4 + fq));
  };
#define MM(a, b, mh) _Pragma("unroll") for (int mf = 0; mf < 4; ++mf) _Pragma("unroll") for (int nf = 0; nf < NF; ++nf) \
    acc[(mh) * 4 + mf][nf] = __builtin_amdgcn_mfma_f32_16x16x32_bf16(a[mf], b[nf], acc[(mh) * 4 + mf][nf], 0, 0, 0);
  al.issue(0, smem); issueB(0, smem + ASZ); al.commit(smem);
  asm volatile("s_waitcnt vmcnt(0)" ::: "memory");
  __syncthreads();
  rdA(A0, smem, 0, 0); rdB(B0, smem, 0);
  for (int kt = 0; kt < KT; ++kt) {
    char* cur = smem + (kt & 1) * STG; char* nxt = smem + ((kt + 1) & 1) * STG;
    const bool more = kt + 1 < KT;
    if (more) { al.issue(kt + 1, nxt); issueB(kt + 1, nxt + ASZ); }
    rdA(A1, cur, 0, 1); SB();
    MM(A0, B0, 0) SB();
    rdA(A0, cur, 1, 0); rdB(B1, cur, 1); SB();
    MM(A1, B0, 1) SB();
    rdA(A1, cur, 1, 1); SB();
    MM(A0, B1, 0) SB();
    if (more) al.commit(nxt);
    asm volatile("s_waitcnt vmcnt(0) lgkmcnt(0)" ::: "memory");
    __syncthreads();
    if (more) { rdA(A0, nxt, 0, 0); rdB(B0, nxt, 0); }
    SB();
    MM(A1, B1, 1) SB();
  }
#undef MM
  ep.template run<NF, 0>(acc, w);
}

template <int NF, class AL, class EP>
__device__ __forceinline__ void gemm_tile2(char* smem, AL& al0, AL& al1, const u16* __restrict__ Bt, int K, EP& ep0, EP& ep1, int flags = 0) {
  constexpr int ASZ = 32768, STG = ASZ + 8192 * NF;
  int tid = threadIdx.x; asm volatile("" : "+v"(tid));
  const int w = tid >> 6, l = tid & 63, fr = l & 15, fq = l >> 4, mg = w >> 2, wn = w & 3;
  f32x4 acc[8][NF];
#pragma unroll
  for (int i = 0; i < 8; ++i)
#pragma unroll
    for (int j = 0; j < NF; ++j) acc[i][j] = f32x4{0.f, 0.f, 0.f, 0.f};
  const int KT = K >> 6;
  const int wvb = __builtin_amdgcn_readfirstlane((tid >> 6) << 10);
  const unsigned bvoff = ((unsigned)(tid >> 3) * K + ((tid & 7) ^ ((tid >> 4) & 7)) * 8) * 2;
  auto issueB = [&](int kt, char* Bb) {
#pragma unroll
    for (int i = 0; i < NF; ++i) glds16u((const char*)(Bt + (size_t)(64 * i) * K + kt * 64), bvoff, Bb + wvb + i * 8192);
  };
  auto issueBh = [&](int kt, char* Bb, int h) {
#pragma unroll
    for (int i = 0; i < NF; ++i) if ((i >> 1) == h) glds16u((const char*)(Bt + (size_t)(64 * i) * K + kt * 64), bvoff, Bb + wvb + i * 8192);
  };
  bf16x8 Aa[2], Ab[2], B0[NF], B1[NF];
  auto rdA = [&](bf16x8 (&a)[2], const char* buf, int ks, int mp) {
#pragma unroll
    for (int i = 0; i < 2; ++i) a[i] = *(const bf16x8*)(buf + mg * 16384 + swz16((mp * 2 + i) * 16 + fr, ks * 4 + fq));
  };
  auto rdB = [&](bf16x8 (&b)[NF], const char* buf, int ks) {
#pragma unroll
    for (int nf = 0; nf < NF; ++nf) b[nf] = *(const bf16x8*)(buf + ASZ + swz16(wn * 16 * NF + nf * 16 + fr, ks * 4 + fq));
  };
#define MM(a, b, mp) _Pragma("unroll") for (int i = 0; i < 2; ++i) _Pragma("unroll") for (int nf = 0; nf < NF; ++nf) \
    acc[(mp) * 2 + i][nf] = __builtin_amdgcn_mfma_f32_16x16x32_bf16(a[i], b[nf], acc[(mp) * 2 + i][nf], 0, 0, 0);
  al0.issue(0, smem); al1.issue(0, smem + 16384); issueB(0, smem + ASZ); al0.commit(smem); al1.commit(smem + 16384);
  asm volatile("s_waitcnt vmcnt(0)" ::: "memory");
  __syncthreads();
  rdA(Aa, smem, 0, 0); rdB(B0, smem, 0);
  for (int kt = 0; kt < KT; ++kt) {
    char* cur = smem + (kt & 1) * STG; char* nxt = smem + ((kt + 1) & 1) * STG;
    const bool more = kt + 1 < KT;
    const bool ld = more && !(flags & 1);
    if (ld) { al0.issue(kt + 1, nxt); al1.issue(kt + 1, nxt + 16384); }
    rdA(Ab, cur, 0, 1); SB(); MM(Aa, B0, 0) SB();
    rdA(Aa, cur, 0, 2); if (ld) issueB(kt + 1, nxt + ASZ); SB(); MM(Ab, B0, 1) SB();
    rdA(Ab, cur, 0, 3); rdB(B1, cur, 1); SB(); MM(Aa, B0, 2) SB();
    rdA(Aa, cur, 1, 0); SB(); MM(Ab, B0, 3) SB();
    rdA(Ab, cur, 1, 1); SB(); MM(Aa, B1, 0) SB();
    rdA(Aa, cur, 1, 2); SB(); MM(Ab, B1, 1) SB();
    rdA(Ab, cur, 1, 3); SB(); MM(Aa, B1, 2) SB();
    if (more) { al0.commit(nxt); al1.commit(nxt + 16384); }
    asm volatile("s_waitcnt vmcnt(0) lgkmcnt(0)" ::: "memory");
    __syncthreads();
    if (more) { rdA(Aa, nxt, 0, 0); rdB(B0, nxt, 0); }
    SB();
    MM(Ab, B1, 3) SB();
  }
#undef MM
  if (!(flags & 2)) {
    int t2 = threadIdx.x; asm volatile("" : "+v"(t2));
    const int wn2 = (t2 >> 6) & 3;
    if (NF == 4) {
      if ((t2 >> 8) == 0) { ep0.template run<NF, 0>(acc, wn2 * 2); ep0.template run<NF, NF - 2>(acc, wn2 * 2 + 1); }
      else { ep1.template run<NF, 0>(acc, wn2 * 2); ep1.template run<NF, NF - 2>(acc, wn2 * 2 + 1); }
    } else {
      if ((t2 >> 8) == 0) ep0.template run<NF, 0>(acc, wn2); else ep1.template run<NF, 0>(acc, wn2);
    }
  }
}

struct Epi1 {
  char* ws; int nt, b, t0; bool ctx;
  template <int NFT, int F0>
  __device__ __forceinline__ void run(f32x4 (&acc)[8][NFT], int w) {
    int tid = threadIdx.x; asm volatile("" : "+v"(tid));
    const int l = tid & 63, c = l & 15, q4 = l >> 4;
    if (nt < 4) {
      const bool isq = nt < 2;
      const int head = (nt & 1) * 2 + (w >> 2), comp = (w >> 1) & 1, dh = w & 1;
      const float2* rope = (const float2*)(ws + WS_ROPE);
      u16* dst;
      if (isq) { dst = (u16*)(ws + WS_Q) + ((size_t)((b * 4 + head) * 2 + comp) * L + t0) * 64; }
      else { dst = (u16*)(ws + WS_K) + ((size_t)((b * 4 + head) * 2 + comp) * LK + (ctx ? t0 : LC + t0)) * 64; }
      const float sc = isq ? QSCALE : 1.f;
      const unsigned d1 = dh * 32 + c;
#pragma unroll
      for (int mf = 0; mf < 8; ++mf) {
#pragma unroll
        for (int j = 0; j < 4; ++j) {
          unsigned r = mf * 16 + q4 * 4 + j;
          float x1 = acc[mf][F0][j], x2 = acc[mf][F0 + 1][j], o1, o2;
          unsigned t = t0 + r; unsigned pos = dh ? (t & 63) : (t >> 6);
          float2 cs = rope[ctx ? 2048u : pos * 16 + c];
          o1 = x1 * cs.x - x2 * cs.y; o2 = x2 * cs.x + x1 * cs.y;
          dst[r * 64 + d1] = f2bf(o1 * sc);
          dst[r * 64 + d1 + 16] = f2bf(o2 * sc);
        }
        __builtin_amdgcn_sched_barrier(0);
      }
    } else if (nt < 6) {
      const int head = (nt - 4) * 2 + (w >> 2);
      u16* vt = (u16*)(ws + WS_VT);
#pragma unroll
      for (int f = 0; f < 2; ++f) {
        int e = (w & 3) * 32 + f * 16 + c;
        u16* dst = vt + ((size_t)(b * 4 + head) * 128 + e) * LK + (ctx ? t0 : LC + t0);
#pragma unroll
        for (int mf = 0; mf < 8; ++mf) {
          uint2 v; v.x = cvtpk(acc[mf][F0 + f][0], acc[mf][F0 + f][1]); v.y = cvtpk(acc[mf][F0 + f][2], acc[mf][F0 + f][3]);
          *(uint2*)(dst + mf * 16 + q4 * 4) = v;
        }
      }
    } else {
      const int ch = (nt - 6) * 128 + w * 16 + c;
      unsigned* dst = (unsigned*)(ws + WS_FZ) + ((size_t)(b * 512 + ch)) * L + t0;
#pragma unroll
      for (int mf = 0; mf < 8; ++mf) {
        uint4 v;
        v.x = cvtpk(acc[mf][F0][0], acc[mf][F0 + 1][0]); v.y = cvtpk(acc[mf][F0][1], acc[mf][F0 + 1][1]);
        v.z = cvtpk(acc[mf][F0][2], acc[mf][F0 + 1][2]); v.w = cvtpk(acc[mf][F0][3], acc[mf][F0 + 1][3]);
        *(uint4*)(dst + mf * 16 + q4 * 4) = v;
      }
    }
  }
};
__device__ __forceinline__ float dpp_xor1(float v) {
  return __int_as_float(__builtin_amdgcn_mov_dpp(__float_as_int(v), 0xB1, 0xF, 0xF, true));
}
struct EpiRes {
  const float* Xf; const u16* X16; u16* R; const float* gate; int m0, n0;
  template <int NFT, int F0>
  __device__ __forceinline__ void run(f32x4 (&acc)[8][NFT], int w) {
    int tid = threadIdx.x; asm volatile("" : "+v"(tid));
    const int l = tid & 63, c = l & 15, q4 = l >> 4;
    const bool odd = c & 1;
#pragma unroll
    for (int f = 0; f < 2; ++f) {
      const int np = n0 + w * 32 + f * 16 + (c & ~1);
      const float g0 = gate[np], g1 = gate[np + 1];
      const unsigned base = (unsigned)(m0 + q4 * 4 + (odd ? 2 : 0)) * D + np;
#pragma unroll
      for (int mf = 0; mf < 8; ++mf) {
        const float a0 = acc[mf][F0 + f][0], a1 = acc[mf][F0 + f][1], a2 = acc[mf][F0 + f][2], a3 = acc[mf][F0 + f][3];
        const float r0 = dpp_xor1(odd ? a0 : a2), r1 = dpp_xor1(odd ? a1 : a3);
        const float v00 = odd ? r0 : a0, v01 = odd ? a2 : r0;
        const float v10 = odd ? r1 : a1, v11 = odd ? a3 : r1;
        const unsigned i0 = base + (unsigned)(mf * 16) * D, i1 = i0 + D;
        float x00, x01, x10, x11;
        if (Xf) { float2 t0 = *(const float2*)(Xf + i0), t1 = *(const float2*)(Xf + i1); x00 = t0.x; x01 = t0.y; x10 = t1.x; x11 = t1.y; }
        else { unsigned t0 = *(const unsigned*)(X16 + i0), t1 = *(const unsigned*)(X16 + i1); x00 = bflo(t0); x01 = bfhi(t0); x10 = bflo(t1); x11 = bfhi(t1); }
        *(unsigned*)(R + i0) = cvtpk(ALPHA * x00 + g0 * v00, ALPHA * x01 + g1 * v01);
        *(unsigned*)(R + i1) = cvtpk(ALPHA * x10 + g0 * v10, ALPHA * x11 + g1 * v11);
        __builtin_amdgcn_sched_barrier(0);
      }
    }
  }
};
__device__ __forceinline__ float gelu_erf(float x) {
  float z = fabsf(x) * 0.70710678118654752f;
  float t = __builtin_amdgcn_rcpf(1.f + 0.3275911f * z);
  float poly = t * (0.254829592f + t * (-0.284496736f + t * (1.421413741f + t * (-1.453152027f + t * 1.061405429f))));
  float er = 1.f - poly * __builtin_amdgcn_exp2f(-z * z * 1.4426950408889634f);
  er = copysignf(er, x);
  return 0.5f * x * (1.f + er);
}
typedef float f32x2 __attribute__((ext_vector_type(2)));
__device__ __forceinline__ f32x2 gelu2_gate(f32x2 x, f32x2 g) {
  f32x2 ax; ax.x = fabsf(x.x); ax.y = fabsf(x.y);
  f32x2 z = ax * 0.70710678118654752f;
  f32x2 den = z * 0.3275911f + 1.f;
  f32x2 t; t.x = __builtin_amdgcn_rcpf(den.x); t.y = __builtin_amdgcn_rcpf(den.y);
  f32x2 poly = t * 1.061405429f + (-1.453152027f);
  poly = poly * t + 1.421413741f; poly = poly * t + (-0.284496736f); poly = poly * t + 0.254829592f; poly = poly * t;
  f32x2 ez = z * z * (-1.4426950408889634f);
  f32x2 e; e.x = __builtin_amdgcn_exp2f(ez.x); e.y = __builtin_amdgcn_exp2f(ez.y);
  f32x2 er = 1.f - poly * e;
  er.x = copysignf(er.x, x.x); er.y = copysignf(er.y, x.y);
  f32x2 hx = x * 0.5f;
  return (hx * er + hx) * g;
}
template <int NF>
__device__ __forceinline__ void conv_rows(f32x4 (&acc)[8][NF], int f, float w0, float w1, float w2, float bias, f32x4 (&out)[8]) {
  int tl_ = threadIdx.x; asm volatile("" : "+v"(tl_));
  const int l = tl_ & 63, q4 = l >> 4;
#pragma unroll
  for (int mf = 0; mf < 8; ++mf) {
    float sp = (q4 == 3) ? (mf > 0 ? acc[mf > 0 ? mf - 1 : 0][f][3] : 0.f) : acc[mf][f][3];
    float sn = (q4 == 0) ? (mf < 7 ? acc[mf < 7 ? mf + 1 : 7][f][0] : 0.f) : acc[mf][f][0];
    float prev = __shfl(sp, (l - 16) & 63);
    float next = __shfl(sn, (l + 16) & 63);
    float u0 = acc[mf][f][0], u1 = acc[mf][f][1], u2 = acc[mf][f][2], u3 = acc[mf][f][3];
    out[mf][0] = w0 * prev + w1 * u0 + w2 * u1 + bias;
    out[mf][1] = w0 * u0 + w1 * u1 + w2 * u2 + bias;
    out[mf][2] = w0 * u1 + w1 * u2 + w2 * u3 + bias;
    out[mf][3] = w0 * u2 + w1 * u3 + w2 * next + bias;
  }
}
struct EpiFfn {
  u16* H; const float* cw; const float* cb; int b, tbase, nt;
  template <int NFT, int F0>
  __device__ __forceinline__ void run(f32x4 (&acc)[8][NFT], int w) {
    int tid = threadIdx.x; asm volatile("" : "+v"(tid));
    const int l = tid & 63, c = l & 15, q4 = l >> 4;
    const int ch = nt * 128 + w * 16 + c;
    f32x4 a[8], g[8];
    conv_rows<NFT>(acc, F0, cw[ch], cw[2 * FF + ch], cw[4 * FF + ch], cb[ch], a);
    conv_rows<NFT>(acc, F0 + 1, cw[FF + ch], cw[3 * FF + ch], cw[5 * FF + ch], cb[FF + ch], g);
#pragma unroll
    for (int mf = 0; mf < 8; ++mf) {
      f32x2 h01 = gelu2_gate(f32x2{a[mf][0], a[mf][1]}, f32x2{g[mf][0], g[mf][1]});
      f32x2 h23 = gelu2_gate(f32x2{a[mf][2], a[mf][3]}, f32x2{g[mf][2], g[mf][3]});
      const float hv[4] = {h01.x, h01.y, h23.x, h23.y};
#pragma unroll
      for (int j = 0; j < 4; ++j) {
        int r = mf * 16 + q4 * 4 + j; int t = tbase + r;
        if (r >= 1 && r <= 126 && t < L) H[((size_t)b * L + t) * FF + ch] = f2bf(hv[j]);
      }
    }
  }
};
struct EpiHy {
  u16* VXT; u16* X0T; const float* cw; const float* cb; int b, tbase, nt;
  template <int NFT, int F0>
  __device__ __forceinline__ void run(f32x4 (&acc)[8][NFT], int w) {
    int tid = threadIdx.x; asm volatile("" : "+v"(tid));
    const int l = tid & 63, c = l & 15, q4 = l >> 4;
    const int ch = nt * 64 + w * 16 + c;
    f32x4 x0[8], x1[8], v[8];
    conv_rows<3>(acc, 0, cw[ch], cw[3072 + ch], cw[6144 + ch], cb[ch], x0);
    conv_rows<3>(acc, 1, cw[1024 + ch], cw[3072 + 1024 + ch], cw[6144 + 1024 + ch], cb[1024 + ch], x1);
    conv_rows<3>(acc, 2, cw[2048 + ch], cw[3072 + 2048 + ch], cw[6144 + 2048 + ch], cb[2048 + ch], v);
    u16* vd = VXT + ((size_t)b * 1024 + ch) * L;
    u16* xd = X0T + ((size_t)b * 1024 + ch) * L;
#pragma unroll
    for (int mf = 0; mf < 8; ++mf)
#pragma unroll
      for (int pr = 0; pr < 2; ++pr) {
        int r = mf * 16 + q4 * 4 + pr * 2; int t = tbase + r;
        if (r >= 2 && r < 126 && t < L) {
          *(unsigned*)(vd + t) = cvtpk(v[mf][pr * 2] * x1[mf][pr * 2], v[mf][pr * 2 + 1] * x1[mf][pr * 2 + 1]);
          *(unsigned*)(xd + t) = cvtpk(x0[mf][pr * 2], x0[mf][pr * 2 + 1]);
        }
      }
  }
};

__device__ __forceinline__ void phase_gemm1(const Params& p, char* smem) {
  char* ws = p.ws;
  const u16* HA = (const u16*)(ws + WS_HA);
  const u16* W = (const u16*)(ws + WS_W1T);
  const bool xs = (gridDim.x == 256);
  const int xcd = blockIdx.x & 7, jb = blockIdx.x >> 3;
  for (int tt = xs ? jb : blockIdx.x; tt < (xs ? 162 : 1296); tt += xs ? 32 : gridDim.x) {
    int pi, nt;
    if (xs) {
      if (tt < 160) { nt = tt % 10; pi = xcd * 16 + tt / 10; } else { pi = 128 + (xcd >> 1); nt = 2 + (xcd & 1) * 2 + (tt - 160); }
    } else { int idx = tt; if (idx < 1280) { nt = idx % 10; pi = idx / 10; } else { int j = idx - 1280; pi = 128 + (j >> 2); nt = 2 + (j & 3); } }
    Epi1 ep[2]; ALPlain al[2];
#pragma unroll
    for (int g = 0; g < 2; ++g) {
      int mt = 2 * pi + g;
      ep[g].ws = ws; ep[g].nt = nt;
      if (mt < 256) { ep[g].ctx = false; ep[g].b = mt >> 6; ep[g].t0 = (mt & 63) * 128; }
      else { ep[g].ctx = true; ep[g].b = (mt - 256) >> 1; ep[g].t0 = ((mt - 256) & 1) * 128; }
      al[g].base = HA + (size_t)mt * 128 * D; al[g].lda = D;
    }
    gemm_tile2<4>(smem, al[0], al[1], W + (size_t)nt * 256 * D, D, ep[0], ep[1]);
  }
}
template <int AMODE>
__device__ __forceinline__ void phase_gemm_res(const Params& p, char* smem, const u16* A, int K, const u16* Wt, const float* Xf, const u16* X16, u16* R, int gate_layer, int gate_off) {
  char* ws = p.ws;
  const bool xs = (gridDim.x == 256);
  const int xcd = blockIdx.x & 7, jb = blockIdx.x >> 3;
  for (int tt = xs ? jb : blockIdx.x; tt < (xs ? 64 : 512); tt += xs ? 32 : gridDim.x) {
    int idx = xs ? xcd * 64 + tt : tt;
    int nt = idx & 3, pi = idx >> 2;
    int b = pi >> 5;
    EpiRes ep[2];
#pragma unroll
    for (int g = 0; g < 2; ++g) {
      ep[g].Xf = Xf; ep[g].X16 = X16; ep[g].R = R; ep[g].m0 = (2 * pi + g) * 128; ep[g].n0 = nt * 256;
      ep[g].gate = (const float*)(ws + WS_MODV) + ((size_t)gate_layer * 5 + b) * NMOD + gate_off;
    }
    const u16* Bt = Wt + (size_t)nt * 256 * K;
    if (AMODE == 0) {
      ALPlain al[2];
#pragma unroll
      for (int g = 0; g < 2; ++g) { al[g].base = A + (size_t)(2 * pi + g) * 128 * K; al[g].lda = K; }
      gemm_tile2<4>(smem, al[0], al[1], Bt, K, ep[0], ep[1], p.flags);
    } else if (AMODE == 1) {
      ALCat al[2];
#pragma unroll
      for (int g = 0; g < 2; ++g) {
        int mt = 2 * pi + g; int t0 = (mt & 63) * 128;
        al[g].obase = (const u16*)(ws + WS_O) + (size_t)mt * 128 * 512; al[g].ybase = (const u16*)(ws + WS_YT) + (size_t)b * 512 * L + t0; al[g].last = 0;
      }
      gemm_tile2<4>(smem, al[0], al[1], Bt, K, ep[0], ep[1]);
    } else {
      ALTrans al[2];
#pragma unroll
      for (int g = 0; g < 2; ++g) { int mt = 2 * pi + g; int t0 = (mt & 63) * 128; al[g].base = A + (size_t)b * 1024 * L + t0; }
      gemm_tile2<4>(smem, al[0], al[1], Bt, K, ep[0], ep[1]);
    }
  }
}
__device__ __forceinline__ void phase_gemm_ffn_in(const Params& p, char* smem, int layer) {
  char* ws = p.ws;
  const u16* HA = (const u16*)(ws + WS_HA);
  const u16* W = (const u16*)(ws + WS_W3T) + (size_t)layer * 5632 * 1024;
  const bool xs = (gridDim.x == 256);
  const int xcd = blockIdx.x & 7, jb = blockIdx.x >> 3;
  for (int tt = xs ? jb : blockIdx.x; tt < (xs ? 363 : 132 * 22); tt += xs ? 32 : gridDim.x) {
    int nt, pi;
    if (xs) { pi = (xcd & 3) * 33 + tt / 11; nt = (xcd >> 2) * 11 + tt % 11; }
    else { nt = tt % 22; pi = tt / 22; }
    int b = pi / 33;
    EpiFfn ep[2]; ALHalo al[2];
#pragma unroll
    for (int g = 0; g < 2; ++g) {
      int i = (2 * pi + g) - b * 66;
      ep[g].H = (u16*)(ws + WS_H); ep[g].cw = p.in[11] + (size_t)layer * 3 * 2 * FF; ep[g].cb = p.in[12] + (size_t)layer * 2 * FF;
      ep[g].b = b; ep[g].tbase = 126 * i - 1; ep[g].nt = nt;
      al[g].wsb = ws; al[g].hoff = (unsigned)(WS_HA + (size_t)b * L * D * 2); al[g].t0 = ep[g].tbase;
    }
    gemm_tile2<4>(smem, al[0], al[1], W + (size_t)nt * 256 * D, D, ep[0], ep[1], p.flags);
  }
}
__device__ __forceinline__ void phase_gemm_hy_in(const Params& p, char* smem) {
  char* ws = p.ws;
  const u16* W = (const u16*)(ws + WS_W5T);
  const bool xs = (gridDim.x == 256);
  const int xcd = blockIdx.x & 7, jb = blockIdx.x >> 3;
  for (int tt = xs ? jb : blockIdx.x; tt < (xs ? 272 : 136 * 16); tt += xs ? 32 : gridDim.x) {
    int nt, pi;
    if (xs) { pi = (xcd & 3) * 34 + (tt >> 3); nt = (xcd >> 2) * 8 + (tt & 7); }
    else { nt = tt & 15; pi = tt >> 4; }
    int b = pi / 34;
    EpiHy ep[2]; ALHalo al[2];
#pragma unroll
    for (int g = 0; g < 2; ++g) {
      int i = (2 * pi + g) - b * 68;
      ep[g].VXT = (u16*)(ws + WS_VXT); ep[g].X0T = (u16*)(ws + WS_X0T); ep[g].cw = p.in[22]; ep[g].cb = p.in[23];
      ep[g].b = b; ep[g].tbase = 124 * i - 2; ep[g].nt = nt;
      al[g].wsb = ws; al[g].hoff = (unsigned)(WS_HA + (size_t)b * L * D * 2); al[g].t0 = ep[g].tbase;
    }
    gemm_tile2<3>(smem, al[0], al[1], W + (size_t)nt * 192 * D, D, ep[0], ep[1], p.flags);
  }
}

__device__ __forceinline__ void ln_norm(float (&v)[16]) {
  float s = 0.f;
#pragma unroll
  for (int i = 0; i < 16; ++i) s += v[i];
  const float mu = wave_sum(s) * (1.f / D);
  float q = 0.f;
#pragma unroll
  for (int i = 0; i < 16; ++i) { v[i] -= mu; q += v[i] * v[i]; }
  const float rs = rsqrtf(wave_sum(q) * (1.f / D) + LN_EPS);
#pragma unroll
  for (int i = 0; i < 16; ++i) v[i] *= rs;
}
__device__ __forceinline__ void ld8f(const float* p, float* o) {
  float4 a = *(const float4*)p, b = *(const float4*)(p + 4);
  o[0] = a.x; o[1] = a.y; o[2] = a.z; o[3] = a.w; o[4] = b.x; o[5] = b.y; o[6] = b.z; o[7] = b.w;
}
struct LnPar { float g[16], b[16]; };
__device__ __forceinline__ void ln_row(float (&v)[16], const LnPar* par, float* dstf, u16* dst16,
                                       const float* shift, const float* scale, u16* dsth) {
  const int l = threadIdx.x & 63;
  if (par) {
    ln_norm(v);
#pragma unroll
    for (int h = 0; h < 2; ++h) {
#pragma unroll
      for (int e = 0; e < 8; ++e) v[h * 8 + e] = v[h * 8 + e] * par->g[h * 8 + e] + par->b[h * 8 + e];
      if (dstf) {
        *(float4*)(dstf + h * 512 + l * 8) = make_float4(v[h * 8], v[h * 8 + 1], v[h * 8 + 2], v[h * 8 + 3]);
        *(float4*)(dstf + h * 512 + l * 8 + 4) = make_float4(v[h * 8 + 4], v[h * 8 + 5], v[h * 8 + 6], v[h * 8 + 7]);
      }
      if (dst16) *(uint4*)(dst16 + h * 512 + l * 8) = make_uint4(cvtpk(v[h * 8], v[h * 8 + 1]), cvtpk(v[h * 8 + 2], v[h * 8 + 3]), cvtpk(v[h * 8 + 4], v[h * 8 + 5]), cvtpk(v[h * 8 + 6], v[h * 8 + 7]));
    }
  }
  if (dsth) {
    ln_norm(v);
#pragma unroll
    for (int h = 0; h < 2; ++h) {
      float sc[8], sh[8]; ld8f(scale + h * 512 + l * 8, sc); ld8f(shift + h * 512 + l * 8, sh);
      float o[8];
#pragma unroll
      for (int e = 0; e < 8; ++e) o[e] = v[h * 8 + e] * (1.f + sc[e]) + sh[e];
      *(uint4*)(dsth + h * 512 + l * 8) = make_uint4(cvtpk(o[0], o[1]), cvtpk(o[2], o[3]), cvtpk(o[4], o[5]), cvtpk(o[6], o[7]));
    }
  }
}
__device__ __forceinline__ void phase_ln(const Params& p, const float* srcf, const u16* src16, const float* lg, const float* lb, float* dstf, u16* dst16,
                         int mod_layer, int shift_off, int scale_off, bool do_mod, bool with_ctx) {
  char* ws = p.ws;
  const int wg = blockIdx.x * 8 + (threadIdx.x >> 6), nw = gridDim.x * 8, l = threadIdx.x & 63;
  u16* HA = (u16*)(ws + WS_HA);
  const float* modv = (const float*)(ws + WS_MODV) + (size_t)mod_layer * 5 * NMOD;
  const int nrows = with_ctx ? M + NB * LC : M;
  LnPar par;
  if (lg) {
#pragma unroll
    for (int h = 0; h < 2; ++h) { ld8f(lg + h * 512 + l * 8, par.g + h * 8); ld8f(lb + h * 512 + l * 8, par.b + h * 8); }
  }
  auto loadrow = [&](int row, float (&v)[16]) {
    if (row < M && src16) {
#pragma unroll
      for (int h = 0; h < 2; ++h) {
        uint4 t = *(const uint4*)(src16 + (size_t)row * D + h * 512 + l * 8);
        v[h * 8] = bflo(t.x); v[h * 8 + 1] = bfhi(t.x); v[h * 8 + 2] = bflo(t.y); v[h * 8 + 3] = bfhi(t.y);
        v[h * 8 + 4] = bflo(t.z); v[h * 8 + 5] = bfhi(t.z); v[h * 8 + 6] = bflo(t.w); v[h * 8 + 7] = bfhi(t.w);
      }
    } else {
      const float* sp = (row < M) ? srcf + (size_t)row * D : p.in[2] + (size_t)(row - M) * D;
#pragma unroll
      for (int h = 0; h < 2; ++h) ld8f(sp + h * 512 + l * 8, v + h * 8);
    }
  };
  auto dorow = [&](int row, float (&v)[16]) {
    if (row < M) {
      int b = row >> 13;
      ln_row(v, lg ? &par : nullptr, dstf ? dstf + (size_t)row * D : nullptr, dst16 ? dst16 + (size_t)row * D : nullptr,
             modv + (size_t)b * NMOD + shift_off, modv + (size_t)b * NMOD + scale_off, do_mod ? HA + (size_t)row * D : nullptr);
    } else {
      ln_row(v, nullptr, nullptr, nullptr,
             modv + (size_t)4 * NMOD + shift_off, modv + (size_t)4 * NMOD + scale_off, HA + (size_t)row * D);
    }
  };
  for (int row = wg; row < nrows; row += 2 * nw) {
    float v0[16], v1[16];
    const int row1 = row + nw;
    loadrow(row, v0);
    if (row1 < nrows) loadrow(row1, v1);
    dorow(row, v0);
    if (row1 < nrows) dorow(row1, v1);
  }
}

__device__ __forceinline__ int swap23(int x) { return (x & ~12) | ((x & 4) << 1) | ((x & 8) >> 1); }
__device__ __forceinline__ void attn_unit(const Params& p, char* smem, int b, int h, int qb) {
  char* ws = p.ws;
  const int tid = threadIdx.x, w = tid >> 6, l = tid & 63, comp = w >> 2, qf = w & 3, r32 = l & 31, hh = l >> 5;
  const int wvb = __builtin_amdgcn_readfirstlane((tid >> 6) << 10);
  const int bh = b * 4 + h;
  const u16* Qg = (const u16*)(ws + WS_Q) + ((size_t)(bh * 2 + comp) * L + qb * 128 + qf * 32 + r32) * 64;
  bf16x8 qfrag[4];
#pragma unroll
  for (int s = 0; s < 4; ++s) qfrag[s] = *(const bf16x8*)(Qg + 16 * s + 8 * hh);
  const int prow = tid >> 3, pc = tid & 7;
  const unsigned koff = (unsigned)(swap23(prow) * 128 + ((pc ^ ((prow >> 1) & 7)) << 4));
  const unsigned k1base = (unsigned)(WS_K + (size_t)(bh * 2) * LK * 128) + koff;
  const unsigned k2base = k1base + (unsigned)(LK * 128);
  const unsigned vbase = (unsigned)(WS_VT + (size_t)bh * 128 * LK * 2) + (unsigned)prow * (LK * 2) + ((pc ^ ((prow >> 1) & 7)) << 4);
  auto issueT = [&](int it) {
    char* slot = smem + (it & 3) * 32768 + wvb;
    glds16u(ws, k1base + (unsigned)it * 8192u, slot);
    glds16u(ws, k2base + (unsigned)it * 8192u, slot + 8192);
    glds16u(ws, vbase + (unsigned)it * 128u, slot + 16384);
    glds16u(ws, vbase + (unsigned)it * 128u + 64u * (LK * 2), slot + 24576);
  };
  f32x16 o[4];
#pragma unroll
  for (int i = 0; i < 4; ++i)
#pragma unroll
    for (int j = 0; j < 16; ++j) o[i][j] = 0.f;
  float mrun = 0.f, lsum = 0.f;
  constexpr int NIT = LK / 64;
  constexpr float THR = 8.f;
  auto qk = [&](f32x16& s0, f32x16& s1, int it, float init) {
    const char* Kb = smem + (it & 3) * 32768 + comp * 8192;
    bf16x8 a0[4], a1[4];
#pragma unroll
    for (int s = 0; s < 4; ++s) { a0[s] = *(const bf16x8*)(Kb + swz16(r32, 2 * s + hh)); a1[s] = *(const bf16x8*)(Kb + swz16(32 + r32, 2 * s + hh)); }
#pragma unroll
    for (int j = 0; j < 16; ++j) { s0[j] = init; s1[j] = init; }
#pragma unroll
    for (int s = 0; s < 4; ++s) {
      s0 = __builtin_amdgcn_mfma_f32_32x32x16_bf16(a0[s], qfrag[s], s0, 0, 0, 0);
      s1 = __builtin_amdgcn_mfma_f32_32x32x16_bf16(a1[s], qfrag[s], s1, 0, 0, 0);
    }
  };
#define ABAR() do { __builtin_amdgcn_s_barrier(); asm volatile("" ::: "memory"); } while (0)
  bf16x8 pb[2][2];
  auto half1 = [&](f32x16& c0, f32x16& c1, f32x16& n0, f32x16& n1, int it) {
    if (comp == 1 && it + 3 < NIT) issueT(it + 3);
    float mx = c0[0];
#pragma unroll
    for (int j = 1; j < 16; ++j) mx = fmaxf(mx, c0[j]);
#pragma unroll
    for (int j = 0; j < 16; ++j) mx = fmaxf(mx, c1[j]);
    { auto rr = __builtin_amdgcn_permlane32_swap(__float_as_uint(mx), __float_as_uint(mx), false, false);
      mx = fmaxf(__uint_as_float(rr[0]), __uint_as_float(rr[1])); }
    if (__builtin_expect(__any((mx > THR) || (it == 0)), 0)) {
      const float d = (it == 0) ? mx : fmaxf(mx, 0.f);
      const float al = __builtin_amdgcn_exp2f(-d);
      mrun += d; lsum *= al;
#pragma unroll
      for (int j = 0; j < 16; ++j) { c0[j] -= d; c1[j] -= d; }
#pragma unroll
      for (int i = 0; i < 4; ++i)
#pragma unroll
        for (int j = 0; j < 16; ++j) o[i][j] *= al;
    }
    if (it + 1 < NIT) qk(n0, n1, it + 1, -mrun);
    float ps = 0.f;
#pragma unroll
    for (int j = 0; j < 16; ++j) { c0[j] = __builtin_amdgcn_exp2f(c0[j]); ps += c0[j]; }
#pragma unroll
    for (int j = 0; j < 16; ++j) { c1[j] = __builtin_amdgcn_exp2f(c1[j]); ps += c1[j]; }
    lsum += ps;
#pragma unroll
    for (int s2 = 0; s2 < 2; ++s2) {
      uint4 u = make_uint4(cvtpk(c0[8 * s2], c0[8 * s2 + 1]), cvtpk(c0[8 * s2 + 2], c0[8 * s2 + 3]), cvtpk(c0[8 * s2 + 4], c0[8 * s2 + 5]), cvtpk(c0[8 * s2 + 6], c0[8 * s2 + 7]));
      pb[0][s2] = *(bf16x8*)&u;
      uint4 u2 = make_uint4(cvtpk(c1[8 * s2], c1[8 * s2 + 1]), cvtpk(c1[8 * s2 + 2], c1[8 * s2 + 3]), cvtpk(c1[8 * s2 + 4], c1[8 * s2 + 5]), cvtpk(c1[8 * s2 + 6], c1[8 * s2 + 7]));
      pb[1][s2] = *(bf16x8*)&u2;
    }
#pragma unroll
    for (int g = 0; g < 8; ++g) { __builtin_amdgcn_sched_group_barrier(0x008, 1, 0); __builtin_amdgcn_sched_group_barrier(0x002, 12, 0); }
    if (comp == 1) {
      if (it + 3 < NIT) asm volatile("s_waitcnt vmcnt(4) lgkmcnt(0)" ::: "memory");
      else asm volatile("s_waitcnt vmcnt(0) lgkmcnt(0)" ::: "memory");
    } else asm volatile("s_waitcnt lgkmcnt(0)" ::: "memory");
    ABAR();
  };
  auto half2 = [&](int it) {
    if (comp == 0 && it + 3 < NIT) issueT(it + 3);
    const char* Vb = smem + (it & 3) * 32768 + 16384;
    bf16x8 va[4], vb2[4];
    auto rdV = [&](bf16x8 (&v)[4], int k) {
#pragma unroll
      for (int ef = 0; ef < 4; ++ef) v[ef] = *(const bf16x8*)(Vb + swz16(ef * 32 + r32, 2 * k + hh));
    };
    rdV(va, 0); rdV(vb2, 1); SB();
#pragma unroll
    for (int ef = 0; ef < 4; ++ef) o[ef] = __builtin_amdgcn_mfma_f32_32x32x16_bf16(va[ef], pb[0][0], o[ef], 0, 0, 0);
    SB(); rdV(va, 2); SB();
#pragma unroll
    for (int ef = 0; ef < 4; ++ef) o[ef] = __builtin_amdgcn_mfma_f32_32x32x16_bf16(vb2[ef], pb[0][1], o[ef], 0, 0, 0);
    SB(); rdV(vb2, 3); SB();
#pragma unroll
    for (int ef = 0; ef < 4; ++ef) o[ef] = __builtin_amdgcn_mfma_f32_32x32x16_bf16(va[ef], pb[1][0], o[ef], 0, 0, 0);
    SB();
#pragma unroll
    for (int ef = 0; ef < 4; ++ef) o[ef] = __builtin_amdgcn_mfma_f32_32x32x16_bf16(vb2[ef], pb[1][1], o[ef], 0, 0, 0);
    if (comp == 0) {
      if (it + 3 < NIT) asm volatile("s_waitcnt vmcnt(4) lgkmcnt(0)" ::: "memory");
      else asm volatile("s_waitcnt vmcnt(0) lgkmcnt(0)" ::: "memory");
    } else asm volatile("s_waitcnt lgkmcnt(0)" ::: "memory");
    ABAR();
  };
  issueT(0); issueT(1); issueT(2);
  asm volatile("s_waitcnt vmcnt(0) lgkmcnt(0)" ::: "memory");
  ABAR();
  f32x16 sa0, sa1, sb0, sb1;
  qk(sa0, sa1, 0, 0.f);
  if (comp == 1) { asm volatile("s_waitcnt lgkmcnt(0)" ::: "memory"); ABAR(); }
  for (int it = 0; it < NIT; it += 2) {
    half1(sa0, sa1, sb0, sb1, it);
    half2(it);
    half1(sb0, sb1, sa0, sa1, it + 1);
    half2(it + 1);
  }
  if (comp == 0) ABAR();
  __syncthreads();
  float ltot = lsum + swap32_f(lsum);
  float inv = 1.f / ltot;
  float* X = (float*)smem;
  if (comp == 1) {
#pragma unroll
    for (int ef = 0; ef < 4; ++ef)
#pragma unroll
      for (int j = 0; j < 16; ++j) {
        int e = ef * 32 + (j & 3) + 8 * (j >> 2) + 4 * hh;
        X[(qf * 128 + e) * 32 + r32] = o[ef][j] * inv;
      }
  }
  __syncthreads();
  if (comp == 0) {
    const float lam = *(const float*)(ws + WS_MISC);
    float ss = 0.f;
#pragma unroll
    for (int ef = 0; ef < 4; ++ef)
#pragma unroll
      for (int j = 0; j < 16; ++j) {
        int e = ef * 32 + (j & 3) + 8 * (j >> 2) + 4 * hh;
        float val = o[ef][j] * inv - lam * X[(qf * 128 + e) * 32 + r32];
        o[ef][j] = val; ss += val * val;
      }
    ss += swap32_f(ss);
    float rms = rsqrtf(ss * (1.f / 128.f) + LN_EPS) * 0.8f;
    const float* sg = p.in[20];
    u16* dst = (u16*)(ws + WS_O) + ((size_t)b * L + qb * 128 + qf * 32 + r32) * 512 + h * 128;
#pragma unroll
    for (int ef = 0; ef < 4; ++ef)
#pragma unroll
      for (int jg = 0; jg < 4; ++jg) {
        int e = ef * 32 + 8 * jg + 4 * hh;
        float4 g = *(const float4*)(sg + e);
        uint2 ov;
        ov.x = cvtpk(o[ef][4 * jg] * rms * g.x, o[ef][4 * jg + 1] * rms * g.y);
        ov.y = cvtpk(o[ef][4 * jg + 2] * rms * g.z, o[ef][4 * jg + 3] * rms * g.w);
        *(uint2*)(dst + e) = ov;
      }
  }
  __syncthreads();
}

__device__ __forceinline__ float2 cmul(float2 a, float2 b) { return make_float2(a.x * b.x - a.y * b.y, a.x * b.y + a.y * b.x); }
__device__ __forceinline__ float2 twid(float frac) {
  return make_float2(__builtin_amdgcn_cosf(frac), -__builtin_amdgcn_sinf(frac));
}
template <int N>
__device__ __forceinline__ void fft_fwd(float2* s) {
  const int tid = threadIdx.x;
  constexpr int LOGN = (N == 8192) ? 13 : 14;
  int Ns = N;
  if (LOGN & 1) {
    constexpr int H = N / 2;
    for (int j = tid; j < H; j += NTH) {
      float2 a = s[j], b = s[j + H];
      float2 wv = twid((float)j * (1.f / N));
      s[j] = make_float2(a.x + b.x, a.y + b.y);
      s[j + H] = cmul(make_float2(a.x - b.x, a.y - b.y), wv);
    }
    Ns = H;
    __syncthreads();
  }
  for (; Ns >= 4; Ns >>= 2) {
    const int q = Ns >> 2;
    const int lq = 31 - __builtin_clz(q);
    const float invNs = 1.f / (float)Ns;
#pragma unroll 4
    for (int idx = tid; idx < N / 4; idx += NTH) {
      int g = idx >> lq, j = idx & (q - 1); int base = g * Ns + j;
      float2 a0 = s[base], a1 = s[base + q], a2 = s[base + 2 * q], a3 = s[base + 3 * q];
      float2 w1 = twid((float)j * invNs), w2 = cmul(w1, w1), w3 = cmul(w2, w1);
      float2 t0 = make_float2(a0.x + a2.x, a0.y + a2.y), t1 = make_float2(a0.x - a2.x, a0.y - a2.y);
      float2 t2 = make_float2(a1.x + a3.x, a1.y + a3.y), t3 = make_float2(a1.x - a3.x, a1.y - a3.y);
      float2 b0 = make_float2(t0.x + t2.x, t0.y + t2.y);
      float2 b2 = make_float2(t0.x - t2.x, t0.y - t2.y);
      float2 b1 = make_float2(t1.x + t3.y, t1.y - t3.x);
      float2 b3 = make_float2(t1.x - t3.y, t1.y + t3.x);
      s[base] = b0; s[base + q] = cmul(b1, w1); s[base + 2 * q] = cmul(b2, w2); s[base + 3 * q] = cmul(b3, w3);
    }
    __syncthreads();
  }
}
template <int N>
__device__ __forceinline__ void fft_inv(float2* s) {
  const int tid = threadIdx.x;
  for (int Ns = 4; Ns <= N; Ns <<= 2) {
    const int q = Ns >> 2;
    const int lq = 31 - __builtin_clz(q);
    const float invNs = 1.f / (float)Ns;
#pragma unroll 4
    for (int idx = tid; idx < N / 4; idx += NTH) {
      int g = idx >> lq, j = idx & (q - 1); int base = g * Ns + j;
      float2 w1 = twid((float)j * invNs); w1.y = -w1.y;
      float2 w2 = cmul(w1, w1), w3 = cmul(w2, w1);
      float2 a0 = s[base], a1 = cmul(s[base + q], w1), a2 = cmul(s[base + 2 * q], w2), a3 = cmul(s[base + 3 * q], w3);
      float2 t0 = make_float2(a0.x + a2.x, a0.y + a2.y), t1 = make_float2(a0.x - a2.x, a0.y - a2.y);
      float2 t2 = make_float2(a1.x + a3.x, a1.y + a3.y), t3 = make_float2(a1.x - a3.x, a1.y - a3.y);
      s[base] = make_float2(t0.x + t2.x, t0.y + t2.y);
      s[base + 2 * q] = make_float2(t0.x - t2.x, t0.y - t2.y);
      s[base + q] = make_float2(t1.x - t3.y, t1.y + t3.x);
      s[base + 3 * q] = make_float2(t1.x + t3.y, t1.y - t3.x);
    }
    __syncthreads();
  }
}

__device__ __forceinline__ void fourier_unit(const Params& p, char* smem, int unit) {
  char* ws = p.ws;
  float2* s = (float2*)smem;
  const int tid = threadIdx.x;
  const unsigned* src = (const unsigned*)(ws + WS_FZ) + (size_t)unit * L;
  for (int t = tid * 4; t < L; t += NTH * 4) {
    uint4 v = *(const uint4*)(src + t);
    s[t] = make_float2(bflo(v.x), bfhi(v.x)); s[t + 1] = make_float2(bflo(v.y), bfhi(v.y));
    s[t + 2] = make_float2(bflo(v.z), bfhi(v.z)); s[t + 3] = make_float2(bflo(v.w), bfhi(v.w));
  }
  __syncthreads();
  fft_fwd<8192>(s);
  u16* dst = (u16*)(ws + WS_YT) + (size_t)unit * L;
  for (int k0 = tid * 2; k0 < L; k0 += NTH * 2) {
    float v[2];
#pragma unroll
    for (int i = 0; i < 2; ++i) {
      int k = k0 + i; int m1 = k & 1; int k1 = k >> 1;
      int pp = (m1 << 12) | ((k1 & 3) << 10) | (((k1 >> 2) & 3) << 8) | (((k1 >> 4) & 3) << 6) | (((k1 >> 6) & 3) << 4) | (((k1 >> 8) & 3) << 2) | ((k1 >> 10) & 3);
      v[i] = s[pp].x * (1.f / 1024.f);
    }
    *(unsigned*)(dst + k0) = cvtpk(v[0], v[1]);
  }
  __syncthreads();
}

__device__ __forceinline__ void phase_attn_fourier(const Params& p, char* smem) {
  if (gridDim.x == 256) {
    const int xcd = blockIdx.x & 7, j = blockIdx.x >> 3;
    for (int i = 0; i < 4; ++i) {
      int local = j + 32 * i; int pair = 2 * xcd + (local >> 6), qb = local & 63;
      attn_unit(p, smem, pair >> 2, pair & 3, qb);
    }
  } else {
    for (int u = blockIdx.x; u < 1024; u += gridDim.x) attn_unit(p, smem, u >> 8, (u >> 6) & 3, u & 63);
  }
  for (int u = blockIdx.x; u < NB * 512; u += gridDim.x) fourier_unit(p, smem, u);
}

__device__ __forceinline__ void phase_hyena_fft(const Params& p, char* smem) {
  char* ws = p.ws;
  float2* s = (float2*)smem;
  float* red = (float*)(smem + 131072);
  const int tid = threadIdx.x;
  constexpr int N = 16384;
  const float* HT = (const float*)(ws + WS_HT);
  const u16* VXT = (const u16*)(ws + WS_VXT);
  const u16* X0T = (const u16*)(ws + WS_X0T);
  u16* GT = (u16*)(ws + WS_GT);
  for (int c = blockIdx.x; c < 1024; c += gridDim.x) {
    const float* hf = HT + (size_t)c * L;
    const float* hb = HT + (size_t)(1024 + c) * L;
    float l1 = 0.f;
    for (int n = tid; n < N; n += NTH) {
      float v = (n < L) ? hf[n] : ((n == L) ? 0.f : hb[N - n]);
      s[n] = make_float2(v, 0.f); l1 += fabsf(v);
    }
    l1 = wave_sum(l1);
    if ((tid & 63) == 0) red[tid >> 6] = l1;
    __syncthreads();
    float tot = 0.f;
#pragma unroll
    for (int i = 0; i < 8; ++i) tot += red[i];
    fft_fwd<N>(s);
    const float scale = 1.f / (tot * (float)N);
    float2* kspec = (float2*)(ws + WS_KSPEC) + (size_t)blockIdx.x * N;
#pragma unroll 4
    for (int i = 0; i < 32; ++i) { float2 v = s[tid + NTH * i]; kspec[tid + NTH * i] = make_float2(v.x * scale, v.y * scale); }
    __syncthreads();
    const float dsk = p.in[32][c];
#pragma unroll 1
    for (int pair = 0; pair < 2; ++pair) {
      const u16* v0 = VXT + ((size_t)(2 * pair) * 1024 + c) * L;
      const u16* v1 = VXT + ((size_t)(2 * pair + 1) * 1024 + c) * L;
      for (int t = tid * 8; t < L; t += NTH * 8) {
        uint4 a = *(const uint4*)(v0 + t), bq = *(const uint4*)(v1 + t);
        s[t] = make_float2(bflo(a.x), bflo(bq.x)); s[t + 1] = make_float2(bfhi(a.x), bfhi(bq.x));
        s[t + 2] = make_float2(bflo(a.y), bflo(bq.y)); s[t + 3] = make_float2(bfhi(a.y), bfhi(bq.y));
        s[t + 4] = make_float2(bflo(a.z), bflo(bq.z)); s[t + 5] = make_float2(bfhi(a.z), bfhi(bq.z));
        s[t + 6] = make_float2(bflo(a.w), bflo(bq.w)); s[t + 7] = make_float2(bfhi(a.w), bfhi(bq.w));
      }
      for (int t = L + tid; t < N; t += NTH) s[t] = make_float2(0.f, 0.f);
      __syncthreads();
      fft_fwd<N>(s);
#pragma unroll 4
      for (int i = 0; i < 32; ++i) { int pp = tid + NTH * i; s[pp] = cmul(s[pp], kspec[pp]); }
      __syncthreads();
      fft_inv<N>(s);
      const u16* x0a = X0T + ((size_t)(2 * pair) * 1024 + c) * L;
      const u16* x0b = X0T + ((size_t)(2 * pair + 1) * 1024 + c) * L;
      u16* g0 = GT + ((size_t)(2 * pair) * 1024 + c) * L;
      u16* g1 = GT + ((size_t)(2 * pair + 1) * 1024 + c) * L;
      for (int t = tid * 2; t < L; t += NTH * 2) {
        unsigned va = *(const unsigned*)(v0 + t), vb = *(const unsigned*)(v1 + t);
        unsigned xa = *(const unsigned*)(x0a + t), xb = *(const unsigned*)(x0b + t);
        float2 y0 = s[t], y1 = s[t + 1];
        *(unsigned*)(g0 + t) = cvtpk((y0.x + bflo(va) * dsk) * bflo(xa), (y1.x + bfhi(va) * dsk) * bfhi(xa));
        *(unsigned*)(g1 + t) = cvtpk((y0.y + bflo(vb) * dsk) * bflo(xb), (y1.y + bfhi(vb) * dsk) * bfhi(xb));
      }
      __syncthreads();
    }
  }
}

template <int MAP>
__device__ __forceinline__ int orig_col(int n) {
  if (MAP == 0) return n;
  if (MAP == 1) { int f = (n >> 4) & 1; int ch = (n >> 8) * 128 + ((n >> 5) & 7) * 16 + (n & 15); return f * FF + ch; }
  { int nt = n / 192, rem = n - nt * 192; int wv = rem / 48, r2 = rem - wv * 48; int f = r2 >> 4; int ch = nt * 64 + wv * 16 + (r2 & 15); return f * 1024 + ch; }
}
template <int MAP>
__device__ __forceinline__ void transpose_tile(const float* W, int ldw, u16* Wt, int K, int k0, int n0, float* tl) {
  const int tid = threadIdx.x;
#pragma unroll
  for (int i = 0; i < 8; ++i) {
    int idx = tid + NTH * i; int kk = idx >> 6, nn = idx & 63;
    tl[nn * 65 + kk] = W[(size_t)(k0 + kk) * ldw + orig_col<MAP>(n0 + nn)];
  }
  __syncthreads();
#pragma unroll
  for (int i = 0; i < 8; ++i) {
    int idx = tid + NTH * i; int nn = idx >> 6, kk = idx & 63;
    Wt[(size_t)(n0 + nn) * K + k0 + kk] = f2bf(tl[nn * 65 + kk]);
  }
  __syncthreads();
}

__device__ __forceinline__ void phase_prep(const Params& p, char* smem) {
  char* ws = p.ws;
  const int tid = threadIdx.x;
  float* tl = (float*)smem;
  constexpr int T_W1 = 16 * 24, T_W2 = 256, T_W3 = 16 * 88, T_W4 = 44 * 16, T_W5 = 16 * 48, T_W6 = 256;
  constexpr int O_W1 = 0, O_W2 = O_W1 + T_W1, O_W3 = O_W2 + T_W2, O_W4 = O_W3 + 2 * T_W3, O_W5 = O_W4 + 2 * T_W4, O_W6 = O_W5 + T_W5;
  constexpr int O_FOLD = O_W6 + T_W6, O_MOD = O_FOLD + 256, O_HY = O_MOD + 192, O_MISC = O_HY + 256, O_END = O_MISC + 1;
  for (int item = blockIdx.x; item < O_END; item += gridDim.x) {
    if (item < O_W2) { int j = item - O_W1; transpose_tile<0>(p.in[14], 2048, (u16*)(ws + WS_W1T), 1024, (j & 15) * 64, (j >> 4) * 64, tl); }
    else if (item < O_W3) { int j = item - O_W2; transpose_tile<0>(p.in[15], 1024, (u16*)(ws + WS_W2T), 1024, (j & 15) * 64, (j >> 4) * 64, tl); }
    else if (item < O_W4) { int j = item - O_W3; int layer = j / T_W3; j -= layer * T_W3;
      transpose_tile<1>(p.in[10] + (size_t)layer * 1024 * 5632, 5632, (u16*)(ws + WS_W3T) + (size_t)layer * 5632 * 1024, 1024, (j & 15) * 64, (j >> 4) * 64, tl); }
    else if (item < O_W5) { int j = item - O_W4; int layer = j / T_W4; j -= layer * T_W4;
      transpose_tile<0>(p.in[13] + (size_t)layer * 2816 * 1024, 1024, (u16*)(ws + WS_W4T) + (size_t)layer * 1024 * 2816, 2816, (j % 44) * 64, (j / 44) * 64, tl); }
    else if (item < O_W6) { int j = item - O_W5; transpose_tile<2>(p.in[21], 3072, (u16*)(ws + WS_W5T), 1024, (j & 15) * 64, (j >> 4) * 64, tl); }
    else if (item < O_FOLD) { int j = item - O_W6; transpose_tile<0>(p.in[33], 1024, (u16*)(ws + WS_W6T), 1024, (j & 15) * 64, (j >> 4) * 64, tl); }
    else if (item < O_MOD) {
      int j = item - O_FOLD; int g = j >> 6, k0 = (j & 63) * 16;
      float* wl = tl;
      float* cs = tl + 2048;
      for (int i = tid; i < 2048; i += NTH) { int kk = i >> 7, cc = i & 127; wl[i] = p.in[14][(size_t)(k0 + kk) * 2048 + 1536 + g * 128 + cc]; }
      if (tid < 128) { float sv, cv; sincospif((float)tid * (1.f / 64.f), &sv, &cv); cs[tid] = cv; cs[128 + tid] = sv; }
      __syncthreads();
      {
        int m = tid & 127, fsel = (tid >> 7) & 1, kh = tid >> 8;
        float accv[8];
#pragma unroll
        for (int i = 0; i < 8; ++i) accv[i] = 0.f;
        for (int cc = 0; cc < 128; ++cc) {
          float tw = fsel ? -cs[128 + ((m * cc) & 127)] : cs[(m * cc) & 127];
#pragma unroll
          for (int i = 0; i < 8; ++i) accv[i] += wl[(kh * 8 + i) * 128 + cc] * tw;
        }
        int ch = g * 128 + m;
        int nprime = 1536 + (ch >> 7) * 256 + ((ch >> 4) & 7) * 32 + fsel * 16 + (ch & 15);
        u16* dst = (u16*)(ws + WS_W1T) + (size_t)nprime * 1024 + k0 + kh * 8;
        uint4 ov; ov.x = cvtpk(accv[0], accv[1]); ov.y = cvtpk(accv[2], accv[3]); ov.z = cvtpk(accv[4], accv[5]); ov.w = cvtpk(accv[6], accv[7]);
        *(uint4*)dst = ov;
      }
      __syncthreads();
    }
    else if (item < O_HY) {
      int j = item - O_MOD; int layer = j / 96, n0 = (j % 96) * 64;
      float* sv = tl;
      float* red = tl + 5 * 1024;
      for (int i = tid; i < 5 * 1024; i += NTH) {
        int v = i >> 10, k = i & 1023;
        float x = (v < 4) ? p.in[1][v * 1024 + k] : p.in[3][k];
        sv[i] = x / (1.f + __expf(-x));
      }
      __syncthreads();
      int kg = tid >> 6, nn = tid & 63;
      const float* Wm = p.in[4] + (size_t)layer * 1024 * NMOD + n0 + nn;
      float a0 = 0, a1 = 0, a2 = 0, a3 = 0, a4 = 0;
      for (int k0 = kg; k0 < 1024; k0 += 128) {
        float wv[16];
#pragma unroll
        for (int u = 0; u < 16; ++u) wv[u] = Wm[(size_t)(k0 + 8 * u) * NMOD];
#pragma unroll
        for (int u = 0; u < 16; ++u) {
          const int k = k0 + 8 * u;
          a0 += sv[k] * wv[u]; a1 += sv[1024 + k] * wv[u]; a2 += sv[2048 + k] * wv[u]; a3 += sv[3072 + k] * wv[u]; a4 += sv[4096 + k] * wv[u];
        }
      }
      red[(kg * 5 + 0) * 64 + nn] = a0; red[(kg * 5 + 1) * 64 + nn] = a1; red[(kg * 5 + 2) * 64 + nn] = a2; red[(kg * 5 + 3) * 64 + nn] = a3; red[(kg * 5 + 4) * 64 + nn] = a4;
      __syncthreads();
      if (tid < 320) {
        int v = tid >> 6; float sum = 0.f;
#pragma unroll
        for (int g = 0; g < 8; ++g) sum += red[(g * 5 + v) * 64 + nn];
        ((float*)(ws + WS_MODV))[((size_t)layer * 5 + v) * NMOD + n0 + nn] = sum + p.in[5][(size_t)layer * NMOD + n0 + nn];
      }
      __syncthreads();
    }
    else if (item < O_MISC) {
      int j = item - O_HY; int tb = j * 32;
      float* z = tl;
      float* h1 = tl + 32 * 36;
      float* h2 = h1 + 32 * 64;
      float* h3 = h2 + 32 * 64;
      const float* w1 = p.in[24]; const float* b1 = p.in[25]; const float* w2 = p.in[26]; const float* b2 = p.in[27];
      const float* w3 = p.in[28]; const float* b3 = p.in[29]; const float* fr = p.in[30]; const float* w4 = p.in[31];
      for (int i = tid; i < 32 * 33; i += NTH) {
        int tt = i / 33, e = i - tt * 33; int t = tb + tt; float val;
        if (e == 0) val = (float)t / (float)(L - 1);
        else {
          int jb = (e - 1) & 15;
          double fb = 1e-4 + (double)jb * ((15.0 - 1e-4) / 15.0);
          double rev = fb * (double)t / (double)L; rev -= floor(rev);
          float sn, cn; sincospif((float)(2.0 * rev), &sn, &cn);
          val = (e <= 16) ? cn : -sn;
        }
        z[tt * 36 + e] = val;
      }
      __syncthreads();
      for (int i = tid; i < 32 * 64; i += NTH) {
        int tt = i >> 6, o = i & 63; float a = b1[o];
        for (int e = 0; e < 33; ++e) a += z[tt * 36 + e] * w1[e * 64 + o];
        h1[tt * 64 + o] = sinf(fr[o] * a);
      }
      __syncthreads();
      for (int i = tid; i < 32 * 64; i += NTH) {
        int tt = i >> 6, o = i & 63; float a = b2[o];
        for (int e = 0; e < 64; ++e) a += h1[tt * 64 + e] * w2[e * 64 + o];
        h2[tt * 64 + o] = sinf(fr[o] * a);
      }
      __syncthreads();
      for (int i = tid; i < 32 * 64; i += NTH) {
        int tt = i >> 6, o = i & 63; float a = b3[o];
        for (int e = 0; e < 64; ++e) a += h2[tt * 64 + e] * w3[e * 64 + o];
        h3[tt * 64 + o] = sinf(fr[o] * a);
      }
      __syncthreads();
      const float min_decay = -3.0701134573253945f, max_decay = -15.350567286626972f;
      for (int nb = 0; nb < 2; ++nb) {
        const int n0 = nb * 2 * NTH + tid, n1 = n0 + NTH;
        float acc0[32], acc1[32];
#pragma unroll
        for (int tt = 0; tt < 32; ++tt) { acc0[tt] = 0.f; acc1[tt] = 0.f; }
        for (int e4 = 0; e4 < 16; ++e4) {
          const float* wr = w4 + (size_t)(4 * e4) * 2048;
          float wa0 = wr[n0], wb0 = wr[2048 + n0], wc0 = wr[4096 + n0], wd0 = wr[6144 + n0];
          float wa1 = wr[n1], wb1 = wr[2048 + n1], wc1 = wr[4096 + n1], wd1 = wr[6144 + n1];
#pragma unroll
          for (int tt = 0; tt < 32; ++tt) {
            float4 hv = *(const float4*)(h3 + tt * 64 + 4 * e4);
            acc0[tt] += hv.x * wa0 + hv.y * wb0 + hv.z * wc0 + hv.w * wd0;
            acc1[tt] += hv.x * wa1 + hv.y * wb1 + hv.z * wc1 + hv.w * wd1;
          }
        }
#pragma unroll
        for (int half = 0; half < 2; ++half) {
          const int n = half ? n1 : n0;
          int cc = n & 1023;
          float delta = fabsf(min_decay + (float)cc * ((max_decay - min_decay) / 1023.f));
          float* dst = (float*)(ws + WS_HT) + (size_t)n * L + tb;
#pragma unroll
          for (int t4 = 0; t4 < 8; ++t4) {
            float4 ov;
            ov.x = (half ? acc1[4 * t4] : acc0[4 * t4]) * __expf(-delta * (float)(tb + 4 * t4) / (float)(L - 1));
            ov.y = (half ? acc1[4 * t4 + 1] : acc0[4 * t4 + 1]) * __expf(-delta * (float)(tb + 4 * t4 + 1) / (float)(L - 1));
            ov.z = (half ? acc1[4 * t4 + 2] : acc0[4 * t4 + 2]) * __expf(-delta * (float)(tb + 4 * t4 + 2) / (float)(L - 1));
            ov.w = (half ? acc1[4 * t4 + 3] : acc0[4 * t4 + 3]) * __expf(-delta * (float)(tb + 4 * t4 + 3) / (float)(L - 1));
            *(float4*)(dst + 4 * t4) = ov;
          }
        }
      }
      __syncthreads();
    }
    else {
      ((unsigned*)(ws + WS_ZROW))[tid] = 0u;
      if (tid == 0) ((float2*)(ws + WS_ROPE))[2048] = make_float2(1.f, 0.f);
      for (int i = tid; i < 128 * 16; i += NTH) {
        int pos = i >> 4, jj = i & 15;
        float inv = exp2f(-(float)jj * (13.287712379549449f / 16.f));
        float sn, cn; sincosf((float)pos * inv, &sn, &cn);
        ((float2*)(ws + WS_ROPE))[i] = make_float2(cn, sn);
      }
      if (tid < 64) {
        float a = p.in[16][tid] * p.in[17][tid], bq = p.in[18][tid] * p.in[19][tid];
        a = wave_sum(a); bq = wave_sum(bq);
        if (tid == 0) *(float*)(ws + WS_MISC) = expf(a) - expf(bq) + 0.2f;
      }
      __syncthreads();
    }
  }
}

__device__ __forceinline__ void grid_bar(unsigned* ctr) {
  asm volatile("s_waitcnt vmcnt(0) lgkmcnt(0)" ::: "memory");
  __syncthreads();
  if (threadIdx.x == 0) {
    __threadfence();
    __hip_atomic_fetch_add(ctr, 1u, __ATOMIC_RELAXED, __HIP_MEMORY_SCOPE_AGENT);
    while (__hip_atomic_load(ctr, __ATOMIC_RELAXED, __HIP_MEMORY_SCOPE_AGENT) < gridDim.x) __builtin_amdgcn_s_sleep(2);
    __threadfence();
  }
  __syncthreads();
}

__global__ void __launch_bounds__(NTH) fwd_kernel(Params p) {
  extern __shared__ __attribute__((aligned(16))) char smem[];
  cg::grid_group grid = cg::this_grid();
  char* ws = p.ws;
  u16* RX = (u16*)(ws + WS_RX);
#ifdef ONLYP
#define PH(n) if ((n) == ONLYP)
#else
#define PH(n) if (p.ph_lo <= (n) && (n) < p.ph_hi)
#endif
#define SYNC(n) if (p.ph_lo <= (n) && (n) + 1 < p.ph_hi) grid_bar((unsigned*)(ws + WS_BAR) + 64 * (n));
  if (p.ph_hi > 1000) grid.sync();
  PH(0) phase_prep(p, smem);
  SYNC(0)
  PH(1) phase_ln(p, p.in[0], nullptr, nullptr, nullptr, nullptr, nullptr, 0, 0, 1024, true, true);
  SYNC(1)
  PH(2) phase_gemm1(p, smem);
  SYNC(2)
  PH(3) phase_attn_fourier(p, smem);
  SYNC(3)
  PH(4) phase_gemm_res<1>(p, smem, nullptr, 1024, (const u16*)(ws + WS_W2T), p.in[0], nullptr, RX, 0, 2048);
  SYNC(4)
  PH(5) phase_ln(p, nullptr, RX, p.in[6], p.in[7], nullptr, RX, 0, 3072, 4096, true, false);
  SYNC(5)
  PH(6) phase_gemm_ffn_in(p, smem, 0);
  SYNC(6)
  PH(7) phase_gemm_res<0>(p, smem, (const u16*)(ws + WS_H), FF, (const u16*)(ws + WS_W4T), nullptr, RX, RX, 0, 5120);
  SYNC(7)
  PH(8) phase_ln(p, nullptr, RX, p.in[8], p.in[9], nullptr, RX, 1, 0, 1024, true, false);
  SYNC(8)
  PH(9) phase_gemm_hy_in(p, smem);
  SYNC(9)
  PH(10) phase_hyena_fft(p, smem);
  SYNC(10)
  PH(11) phase_gemm_res<2>(p, smem, (const u16*)(ws + WS_GT), 1024, (const u16*)(ws + WS_W6T), nullptr, RX, RX, 1, 2048);
  SYNC(11)
  PH(12) phase_ln(p, nullptr, RX, p.in[6] + D, p.in[7] + D, nullptr, RX, 1, 3072, 4096, true, false);
  SYNC(12)
  PH(13) phase_gemm_ffn_in(p, smem, 1);
  SYNC(13)
  PH(14) phase_gemm_res<0>(p, smem, (const u16*)(ws + WS_H), FF, (const u16*)(ws + WS_W4T) + (size_t)1024 * FF, nullptr, RX, RX, 1, 5120);
  SYNC(14)
  PH(15) phase_ln(p, nullptr, RX, p.in[8] + D, p.in[9] + D, p.out, nullptr, 1, 0, 0, false, false);
#undef PH
#undef SYNC
}

extern "C" void kernel_launch(void* const* d_in, const int* in_sizes, int n_in, void* d_out, int out_size, void* d_ws, size_t ws_size, hipStream_t stream) {
  static int grid_blocks = 0;
  if (grid_blocks == 0) {
    if (n_in != 34 || ws_size < WS_END) { fprintf(stderr, "kernel_launch: bad n_in %d or ws %zu < %zu\n", n_in, ws_size, (size_t)WS_END); grid_blocks = -1; return; }
    int dev = 0, cus = 0, per_cu = 0;
    hipGetDevice(&dev);
    hipDeviceGetAttribute(&cus, hipDeviceAttributeMultiprocessorCount, dev);
    if (hipFuncSetAttribute((const void*)fwd_kernel, hipFuncAttributeMaxDynamicSharedMemorySize, LDS_BYTES) != hipSuccess) { fprintf(stderr, "hipFuncSetAttribute failed\n"); grid_blocks = -1; return; }
    hipOccupancyMaxActiveBlocksPerMultiprocessor(&per_cu, (const void*)fwd_kernel, NTH, LDS_BYTES);
    if (per_cu < 1) { fprintf(stderr, "occupancy 0\n"); grid_blocks = -1; return; }
    grid_blocks = cus * 1;
  }
  if (grid_blocks < 0) return;
  Params p{};
  for (int i = 0; i < 34; ++i) p.in[i] = (const float*)d_in[i];
  p.out = (float*)d_out; p.ws = (char*)d_ws; p.ph_lo = 0; p.ph_hi = 16;
  if (hipMemsetAsync((char*)d_ws + WS_BAR, 0, 16 * 256, stream) != hipSuccess) { fprintf(stderr, "memset failed\n"); return; }
  void* args[] = {&p};
  hipError_t e = hipLaunchCooperativeKernel((const void*)fwd_kernel, dim3(grid_blocks), dim3(NTH), args, LDS_BYTES, stream);
  if (e != hipSuccess) fprintf(stderr, "cooperative launch failed: %s (grid %d)\n", hipGetErrorString(e), grid_blocks);
#if DUP_PHASE >= 0
  {
    Params q = p; q.ph_lo = DUP_PHASE; q.ph_hi = DUP_PHASE + 1; q.flags = DUP_FLAGS;
    hipLaunchKernelGGL(fwd_kernel, dim3(grid_blocks), dim3(NTH), LDS_BYTES, stream, q);
  }
#endif
}
```

```cpp
#include <hip/hip_runtime.h>
#include <hip/hip_bf16.h>
#include <hip/hip_cooperative_groups.h>
#include <cstdio>
namespace cg = cooperative_groups;

typedef unsigned short u16;
typedef __attribute__((ext_vector_type(8))) short bf16x8;
typedef __attribute__((ext_vector_type(4))) float f32x4;
typedef __attribute__((ext_vector_type(16))) float f32x16;

constexpr int D = 1024, NB = 4, L = 8192, LC = 256, LK = L + LC, M = NB * L;
constexpr int FF = 2816, NMOD = 6144;
constexpr int NTH = 512;
constexpr float ALPHA = 1.4142135623730951f;
constexpr float LN_EPS = 1e-5f;
constexpr float QSCALE = 0.125f * 1.4426950408889634f;

constexpr size_t AL256(size_t x) { return (x + 255) & ~(size_t)255; }
constexpr size_t WS_W1T = 0;
constexpr size_t WS_W2T = WS_W1T + (size_t)2560 * 1024 * 2;
constexpr size_t WS_W3T = WS_W2T + (size_t)1024 * 1024 * 2;
constexpr size_t WS_W4T = WS_W3T + (size_t)2 * 5632 * 1024 * 2;
constexpr size_t WS_W5T = WS_W4T + (size_t)2 * 1024 * 2816 * 2;
constexpr size_t WS_W6T = WS_W5T + (size_t)3072 * 1024 * 2;
constexpr size_t WS_MODV = WS_W6T + (size_t)1024 * 1024 * 2;
constexpr size_t WS_MISC = WS_MODV + AL256((size_t)2 * 5 * NMOD * 4);
constexpr size_t WS_BAR = WS_MISC + 256;
constexpr size_t WS_ZROW = WS_BAR + 16 * 256;
constexpr size_t WS_ROPE = WS_ZROW + 2048;
constexpr size_t WS_HT = WS_ROPE + (size_t)128 * 16 * 8 + 256;
constexpr size_t WS_HA = WS_HT + (size_t)2 * 1024 * 8192 * 4;
constexpr size_t WS_RX = WS_HA + (size_t)33792 * 1024 * 2;
constexpr size_t WS_E = WS_RX + (size_t)M * 1024 * 4;
constexpr size_t WS_Q = WS_E;
constexpr size_t WS_K = WS_Q + (size_t)NB * 4 * 2 * L * 64 * 2;
constexpr size_t WS_VT = WS_K + (size_t)NB * 4 * 2 * LK * 64 * 2;
constexpr size_t WS_FZ = WS_VT + (size_t)NB * 4 * 128 * LK * 2;
constexpr size_t WS_H = WS_E;
constexpr size_t WS_VXT = WS_E;
constexpr size_t WS_X0T = WS_VXT + (size_t)NB * 1024 * L * 2;
constexpr size_t WS_KSPEC = WS_X0T + (size_t)NB * 1024 * L * 2;
constexpr size_t WS_END = WS_E + (size_t)M * FF * 2;
static_assert(WS_KSPEC + (size_t)256 * 16384 * 8 <= WS_END, "kspec fits");
constexpr size_t WS_O = WS_HA;
constexpr size_t WS_YT = WS_HA + (size_t)M * 512 * 2;
constexpr size_t WS_GT = WS_HA;

#ifndef DUP_PHASE
#define DUP_PHASE -1
#endif
#ifndef DUP_FLAGS
#define DUP_FLAGS 0
#endif
constexpr int LDS_BYTES = 131072 + 256;

struct Params {
  const float* in[34];
  float* out;
  char* ws;
  int ph_lo, ph_hi, flags, pad_;
};

__device__ __forceinline__ unsigned cvtpk(float lo, float hi) {
  unsigned r; asm volatile("v_cvt_pk_bf16_f32 %0, %1, %2" : "=v"(r) : "v"(lo), "v"(hi)); return r;
}
__device__ __forceinline__ u16 f2bf(float f) { return (u16)(cvtpk(f, 0.f) & 0xffffu); }
__device__ __forceinline__ float bf2f(unsigned h) { return __uint_as_float(h << 16); }
__device__ __forceinline__ float bflo(unsigned v) { return __uint_as_float(v << 16); }
__device__ __forceinline__ float bfhi(unsigned v) { return __uint_as_float(v & 0xffff0000u); }
__device__ __forceinline__ float wave_sum(float v) {
#pragma unroll
  for (int o = 32; o >= 1; o >>= 1) v += __shfl_xor(v, o);
  return v;
}
__device__ __forceinline__ float swap32_f(float v) {
  return __shfl_xor(v, 32);
}
__device__ __forceinline__ int swz16(int row, int c) { return row * 128 + ((c ^ ((row >> 1) & 7)) << 4); }

__device__ __forceinline__ void glds16(const u16* g, char* lds_wave_base) {
  __builtin_amdgcn_global_load_lds((const unsigned*)g, (__attribute__((address_space(3))) unsigned*)lds_wave_base, 16, 0, 0);
}
__device__ __forceinline__ void glds16u(const char* ubase, unsigned voff, char* lds_wave_base) {
  __builtin_amdgcn_global_load_lds((const unsigned*)(ubase + voff), (__attribute__((address_space(3))) unsigned*)lds_wave_base, 16, 0, 0);
}
struct ALPlain {
  const u16* base; int lda;
  __device__ __forceinline__ void issue(int kt, char* Ab) {
    const int tid = threadIdx.x; const int c = (tid & 7) ^ ((tid >> 4) & 7);
    const int wvb = __builtin_amdgcn_readfirstlane((tid >> 6) << 10);
    const unsigned voff = ((unsigned)(tid >> 3) * lda + c * 8) * 2;
#pragma unroll
    for (int i = 0; i < 2; ++i) glds16u((const char*)(base + (size_t)(64 * i) * lda + kt * 64), voff, Ab + wvb + i * 8192);
  }
  __device__ __forceinline__ void commit(char* Ab) {}
};
struct ALHalo {
  const char* wsb; unsigned hoff  ; int t0;
  __device__ __forceinline__ void issue(int kt, char* Ab) {
    const int tid = threadIdx.x; const int c = (tid & 7) ^ ((tid >> 4) & 7);
    const int wvb = __builtin_amdgcn_readfirstlane((tid >> 6) << 10);
#pragma unroll
    for (int i = 0; i < 2; ++i) {
      int row = (tid >> 3) + 64 * i; int t = t0 + row;
      unsigned off = (t >= 0 && t < L) ? hoff + ((unsigned)t * D + kt * 64 + c * 8) * 2 : (unsigned)WS_ZROW + c * 16;
      glds16u(wsb, off, Ab + wvb + i * 8192);
    }
  }
  __device__ __forceinline__ void commit(char* Ab) {}
};
__device__ __forceinline__ void trans_load(const u16* src  , uint2 (&r)[4]) {
  const int tid = threadIdx.x, kq = tid >> 5, mq = tid & 31;
#pragma unroll
  for (int i = 0; i < 4; ++i) r[i] = *(const uint2*)(src + (size_t)(4 * kq + i) * L + 4 * mq);
}
__device__ __forceinline__ void trans_store(char* Ab, const uint2 (&r)[4]) {
  const int tid = threadIdx.x, kq = tid >> 5, mq = tid & 31;
  uint2 o[4];
  o[0].x = (r[0].x & 0xffffu) | (r[1].x << 16); o[0].y = (r[2].x & 0xffffu) | (r[3].x << 16);
  o[1].x = (r[0].x >> 16) | (r[1].x & 0xffff0000u); o[1].y = (r[2].x >> 16) | (r[3].x & 0xffff0000u);
  o[2].x = (r[0].y & 0xffffu) | (r[1].y << 16); o[2].y = (r[2].y & 0xffffu) | (r[3].y << 16);
  o[3].x = (r[0].y >> 16) | (r[1].y & 0xffff0000u); o[3].y = (r[2].y >> 16) | (r[3].y & 0xffff0000u);
#pragma unroll
  for (int j = 0; j < 4; ++j) { int row = 4 * mq + j; *(uint2*)(Ab + swz16(row, kq >> 1) + (kq & 1) * 8) = o[j]; }
}
struct ALTrans {
  const u16* base; uint2 r[4];
  __device__ __forceinline__ void issue(int kt, char* Ab) { trans_load(base + (size_t)kt * 64 * L, r); }
  __device__ __forceinline__ void commit(char* Ab) { trans_store(Ab, r); }
};
struct ALCat {
  const u16* obase; const u16* ybase; uint4 r[2]; int last;
  __device__ __forceinline__ void issue(int kt, char* Ab) {
    last = kt;
    const int tid = threadIdx.x;
    if (kt < 8) {
#pragma unroll
      for (int i = 0; i < 2; ++i) { int row = (tid >> 3) + 64 * i; r[i] = *(const uint4*)(obase + (size_t)row * 512 + kt * 64 + (tid & 7) * 8); }
    } else {
      const int kq = tid >> 5, mq = tid & 31;
      const u16* src = ybase + (size_t)(kt - 8) * 64 * L + (size_t)(4 * kq) * L + 4 * mq;
      uint2 a = *(const uint2*)(src), b = *(const uint2*)(src + L), c = *(const uint2*)(src + 2 * L), d = *(const uint2*)(src + 3 * L);
      r[0] = make_uint4(a.x, a.y, b.x, b.y); r[1] = make_uint4(c.x, c.y, d.x, d.y);
    }
  }
  __device__ __forceinline__ void commit(char* Ab) {
    const int tid = threadIdx.x;
    if (last < 8) {
#pragma unroll
      for (int i = 0; i < 2; ++i) { int row = (tid >> 3) + 64 * i; *(uint4*)(Ab + swz16(row, tid & 7)) = r[i]; }
    } else {
      uint2 q[4] = {make_uint2(r[0].x, r[0].y), make_uint2(r[0].z, r[0].w), make_uint2(r[1].x, r[1].y), make_uint2(r[1].z, r[1].w)};
      trans_store(Ab, q);
    }
  }
};

#define SB() __builtin_amdgcn_sched_barrier(0)
template <int NF, class AL, class EP>
__device__ __forceinline__ void gemm_tile(char* smem, AL& al, const u16* __restrict__ Bt, int K, EP& ep) {
  constexpr int ASZ = 16384, BSZ = 16384 * NF, STG = ASZ + BSZ;
  const int tid = threadIdx.x, w = tid >> 6, l = tid & 63, fr = l & 15, fq = l >> 4;
  f32x4 acc[8][NF];
#pragma unroll
  for (int i = 0; i < 8; ++i)
#pragma unroll
    for (int j = 0; j < NF; ++j) acc[i][j] = f32x4{0.f, 0.f, 0.f, 0.f};
  const int KT = K >> 6;
  const int wvb = __builtin_amdgcn_readfirstlane((tid >> 6) << 10);
  const unsigned bvoff = ((unsigned)(tid >> 3) * K + ((tid & 7) ^ ((tid >> 4) & 7)) * 8) * 2;
  auto issueB = [&](int kt, char* Bb) {
#pragma unroll
    for (int i = 0; i < 2 * NF; ++i) glds16u((const char*)(Bt + (size_t)(64 * i) * K + kt * 64), bvoff, Bb + wvb + i * 8192);
  };
  bf16x8 A0[4], A1[4], B0[NF], B1[NF];
  auto rdA = [&](bf16x8 (&a)[4], const char* buf, int ks, int mh) {
#pragma unroll
    for (int mf = 0; mf < 4; ++mf) a[mf] = *(const bf16x8*)(buf + swz16((mh * 4 + mf) * 16 + fr, ks * 4 + fq));
  };
  auto rdB = [&](bf16x8 (&b)[NF], const char* buf, int ks) {
#pragma unroll
    for (int nf = 0; nf < NF; ++nf) b[nf] = *(const bf16x8*)(buf + ASZ + swz16(w * 16 * NF + nf * 16 + fr, ks * 4 + fq));
  };
#define MM(a, b, mh) _Pragma("unroll") for (int mf = 0; mf < 4; ++mf) _Pragma("unroll") for (int nf = 0; nf < NF; ++nf) \
    acc[(mh) * 4 + mf][nf] = __builtin_amdgcn_mfma_f32_16x16x32_bf16(a[mf], b[nf], acc[(mh) * 4 + mf][nf], 0, 0, 0);
  al.issue(0, smem); issueB(0, smem + ASZ); al.commit(smem);
  asm volatile("s_waitcnt vmcnt(0)" ::: "memory");
  __syncthreads();
  rdA(A0, smem, 0, 0); rdB(B0, smem, 0);
  for (int kt = 0; kt < KT; ++kt) {
    char* cur = smem + (kt & 1) * STG; char* nxt = smem + ((kt + 1) & 1) * STG;
    const bool more = kt + 1 < KT;
    if (more) { al.issue(kt + 1, nxt); issueB(kt + 1, nxt + ASZ); }
    rdA(A1, cur, 0, 1); SB();
    MM(A0, B0, 0) SB();
    rdA(A0, cur, 1, 0); rdB(B1, cur, 1); SB();
    MM(A1, B0, 1) SB();
    rdA(A1, cur, 1, 1); SB();
    MM(A0, B1, 0) SB();
    if (more) al.commit(nxt);
    asm volatile("s_waitcnt vmcnt(0) lgkmcnt(0)" ::: "memory");
    __syncthreads();
    if (more) { rdA(A0, nxt, 0, 0); rdB(B0, nxt, 0); }
    SB();
    MM(A1, B1, 1) SB();
  }
#undef MM
  ep.template run<NF, 0>(acc, w);
}

template <int NF, class AL, class EP>
__device__ __forceinline__ void gemm_tile2(char* smem, AL& al0, AL& al1, const u16* __restrict__ Bt, int K, EP& ep0, EP& ep1, int flags = 0) {
  constexpr int ASZ = 32768, STG = ASZ + 8192 * NF;
  int tid = threadIdx.x; asm volatile("" : "+v"(tid));
  const int w = tid >> 6, l = tid & 63, fr = l & 15, fq = l >> 4, mg = w >> 2, wn = w & 3;
  f32x4 acc[8][NF];
#pragma unroll
  for (int i = 0; i < 8; ++i)
#pragma unroll
    for (int j = 0; j < NF; ++j) acc[i][j] = f32x4{0.f, 0.f, 0.f, 0.f};
  const int KT = K >> 6;
  const int wvb = __builtin_amdgcn_readfirstlane((tid >> 6) << 10);
  const unsigned bvoff = ((unsigned)(tid >> 3) * K + ((tid & 7) ^ ((tid >> 4) & 7)) * 8) * 2;
  auto issueB = [&](int kt, char* Bb) {
#pragma unroll
    for (int i = 0; i < NF; ++i) glds16u((const char*)(Bt + (size_t)(64 * i) * K + kt * 64), bvoff, Bb + wvb + i * 8192);
  };
  auto issueBh = [&](int kt, char* Bb, int h) {
#pragma unroll
    for (int i = 0; i < NF; ++i) if ((i >> 1) == h) glds16u((const char*)(Bt + (size_t)(64 * i) * K + kt * 64), bvoff, Bb + wvb + i * 8192);
  };
  bf16x8 Aa[2], Ab[2], B0[NF], B1[NF];
  auto rdA = [&](bf16x8 (&a)[2], const char* buf, int ks, int mp) {
#pragma unroll
    for (int i = 0; i < 2; ++i) a[i] = *(const bf16x8*)(buf + mg * 16384 + swz16((mp * 2 + i) * 16 + fr, ks * 4 + fq));
  };
  auto rdB = [&](bf16x8 (&b)[NF], const char* buf, int ks) {
#pragma unroll
    for (int nf = 0; nf < NF; ++nf) b[nf] = *(const bf16x8*)(buf + ASZ + swz16(wn * 16 * NF + nf * 16 + fr, ks * 4 + fq));
  };
#define MM(a, b, mp) _Pragma("unroll") for (int i = 0; i < 2; ++i) _Pragma("unroll") for (int nf = 0; nf < NF; ++nf) \
    acc[(mp) * 2 + i][nf] = __builtin_amdgcn_mfma_f32_16x16x32_bf16(a[i], b[nf], acc[(mp) * 2 + i][nf], 0, 0, 0);
  al0.issue(0, smem); al1.issue(0, smem + 16384); issueB(0, smem + ASZ); al0.commit(smem); al1.commit(smem + 16384);
  asm volatile("s_waitcnt vmcnt(0)" ::: "memory");
  __syncthreads();
  rdA(Aa, smem, 0, 0); rdB(B0, smem, 0);
  for (int kt = 0; kt < KT; ++kt) {
    char* cur = smem + (kt & 1) * STG; char* nxt = smem + ((kt + 1) & 1) * STG;
    const bool more = kt + 1 < KT;
    const bool ld = more && !(flags & 1);
    if (ld) { al0.issue(kt + 1, nxt); al1.issue(kt + 1, nxt + 16384); }
    rdA(Ab, cur, 0, 1); SB(); MM(Aa, B0, 0) SB();
    rdA(Aa, cur, 0, 2); if (ld) issueB(kt + 1, nxt + ASZ); SB(); MM(Ab, B0, 1) SB();
    rdA(Ab, cur, 0, 3); rdB(B1, cur, 1); SB(); MM(Aa, B0, 2) SB();
    rdA(Aa, cur, 1, 0); SB(); MM(Ab, B0, 3) SB();
    rdA(Ab, cur, 1, 1); SB(); MM(Aa, B1, 0) SB();
    rdA(Aa, cur, 1, 2); SB(); MM(Ab, B1, 1) SB();
    rdA(Ab, cur, 1, 3); SB(); MM(Aa, B1, 2) SB();
    if (more) { al0.commit(nxt); al1.commit(nxt + 16384); }
    asm volatile("s_waitcnt vmcnt(0) lgkmcnt(0)" ::: "memory");
    __syncthreads();
    if (more) { rdA(Aa, nxt, 0, 0); rdB(B0, nxt, 0); }
    SB();
    MM(Ab, B1, 3) SB();
  }
#undef MM
  if (!(flags & 2)) {
    int t2 = threadIdx.x; asm volatile("" : "+v"(t2));
    const int wn2 = (t2 >> 6) & 3;
    if (NF == 4) {
      if ((t2 >> 8) == 0) { ep0.template run<NF, 0>(acc, wn2 * 2); ep0.template run<NF, NF - 2>(acc, wn2 * 2 + 1); }
      else { ep1.template run<NF, 0>(acc, wn2 * 2); ep1.template run<NF, NF - 2>(acc, wn2 * 2 + 1); }
    } else {
      if ((t2 >> 8) == 0) ep0.template run<NF, 0>(acc, wn2); else ep1.template run<NF, 0>(acc, wn2);
    }
  }
}

struct Epi1 {
  char* ws; int nt, b, t0; bool ctx;
  template <int NFT, int F0>
  __device__ __forceinline__ void run(f32x4 (&acc)[8][NFT], int w) {
    int tid = threadIdx.x; asm volatile("" : "+v"(tid));
    const int l = tid & 63, c = l & 15, q4 = l >> 4;
    if (nt < 4) {
      const bool isq = nt < 2;
      const int head = (nt & 1) * 2 + (w >> 2), comp = (w >> 1) & 1, dh = w & 1;
      const float2* rope = (const float2*)(ws + WS_ROPE);
      u16* dst;
      if (isq) { dst = (u16*)(ws + WS_Q) + ((size_t)((b * 4 + head) * 2 + comp) * L + t0) * 64; }
      else { dst = (u16*)(ws + WS_K) + ((size_t)((b * 4 + head) * 2 + comp) * LK + (ctx ? t0 : LC + t0)) * 64; }
      const float sc = isq ? QSCALE : 1.f;
      const unsigned d1 = dh * 32 + c;
#pragma unroll
      for (int mf = 0; mf < 8; ++mf) {
#pragma unroll
        for (int j = 0; j < 4; ++j) {
          unsigned r = mf * 16 + q4 * 4 + j;
          float x1 = acc[mf][F0][j], x2 = acc[mf][F0 + 1][j], o1, o2;
          unsigned t = t0 + r; unsigned pos = dh ? (t & 63) : (t >> 6);
          float2 cs = rope[ctx ? 2048u : pos * 16 + c];
          o1 = x1 * cs.x - x2 * cs.y; o2 = x2 * cs.x + x1 * cs.y;
          dst[r * 64 + d1] = f2bf(o1 * sc);
          dst[r * 64 + d1 + 16] = f2bf(o2 * sc);
        }
        __builtin_amdgcn_sched_barrier(0);
      }
    } else if (nt < 6) {
      const int head = (nt - 4) * 2 + (w >> 2);
      u16* vt = (u16*)(ws + WS_VT);
#pragma unroll
      for (int f = 0; f < 2; ++f) {
        int e = (w & 3) * 32 + f * 16 + c;
        u16* dst = vt + ((size_t)(b * 4 + head) * 128 + e) * LK + (ctx ? t0 : LC + t0);
#pragma unroll
        for (int mf = 0; mf < 8; ++mf) {
          uint2 v; v.x = cvtpk(acc[mf][F0 + f][0], acc[mf][F0 + f][1]); v.y = cvtpk(acc[mf][F0 + f][2], acc[mf][F0 + f][3]);
          *(uint2*)(dst + mf * 16 + q4 * 4) = v;
        }
      }
    } else {
      const int ch = (nt - 6) * 128 + w * 16 + c;
      unsigned* dst = (unsigned*)(ws + WS_FZ) + ((size_t)(b * 512 + ch)) * L + t0;
#pragma unroll
      for (int mf = 0; mf < 8; ++mf) {
        uint4 v;
        v.x = cvtpk(acc[mf][F0][0], acc[mf][F0 + 1][0]); v.y = cvtpk(acc[mf][F0][1], acc[mf][F0 + 1][1]);
        v.z = cvtpk(acc[mf][F0][2], acc[mf][F0 + 1][2]); v.w = cvtpk(acc[mf][F0][3], acc[mf][F0 + 1][3]);
        *(uint4*)(dst + mf * 16 + q4 * 4) = v;
      }
    }
  }
};
__device__ __forceinline__ float dpp_xor1(float v) {
  return __int_as_float(__builtin_amdgcn_mov_dpp(__float_as_int(v), 0xB1, 0xF, 0xF, true));
}
struct EpiRes {
  const float* Xf; const u16* X16; u16* R; const float* gate; int m0, n0;
  template <int NFT, int F0>
  __device__ __forceinline__ void run(f32x4 (&acc)[8][NFT], int w) {
    int tid = threadIdx.x; asm volatile("" : "+v"(tid));
    const int l = tid & 63, c = l & 15, q4 = l >> 4;
    const bool odd = c & 1;
#pragma unroll
    for (int f = 0; f < 2; ++f) {
      const int np = n0 + w * 32 + f * 16 + (c & ~1);
      const float g0 = gate[np], g1 = gate[np + 1];
      const unsigned base = (unsigned)(m0 + q4 * 4 + (odd ? 2 : 0)) * D + np;
#pragma unroll
      for (int mf = 0; mf < 8; ++mf) {
        const float a0 = acc[mf][F0 + f][0], a1 = acc[mf][F0 + f][1], a2 = acc[mf][F0 + f][2], a3 = acc[mf][F0 + f][3];
        const float r0 = dpp_xor1(odd ? a0 : a2), r1 = dpp_xor1(odd ? a1 : a3);
        const float v00 = odd ? r0 : a0, v01 = odd ? a2 : r0;
        const float v10 = odd ? r1 : a1, v11 = odd ? a3 : r1;
        const unsigned i0 = base + (unsigned)(mf * 16) * D, i1 = i0 + D;
        float x00, x01, x10, x11;
        if (Xf) { float2 t0 = *(const float2*)(Xf + i0), t1 = *(const float2*)(Xf + i1); x00 = t0.x; x01 = t0.y; x10 = t1.x; x11 = t1.y; }
        else { unsigned t0 = *(const unsigned*)(X16 + i0), t1 = *(const unsigned*)(X16 + i1); x00 = bflo(t0); x01 = bfhi(t0); x10 = bflo(t1); x11 = bfhi(t1); }
        *(unsigned*)(R + i0) = cvtpk(ALPHA * x00 + g0 * v00, ALPHA * x01 + g1 * v01);
        *(unsigned*)(R + i1) = cvtpk(ALPHA * x10 + g0 * v10, ALPHA * x11 + g1 * v11);
        __builtin_amdgcn_sched_barrier(0);
      }
    }
  }
};
__device__ __forceinline__ float gelu_erf(float x) {
  float z = fabsf(x) * 0.70710678118654752f;
  float t = __builtin_amdgcn_rcpf(1.f + 0.3275911f * z);
  float poly = t * (0.254829592f + t * (-0.284496736f + t * (1.421413741f + t * (-1.453152027f + t * 1.061405429f))));
  float er = 1.f - poly * __builtin_amdgcn_exp2f(-z * z * 1.4426950408889634f);
  er = copysignf(er, x);
  return 0.5f * x * (1.f + er);
}
typedef float f32x2 __attribute__((ext_vector_type(2)));
__device__ __forceinline__ f32x2 gelu2_gate(f32x2 x, f32x2 g) {
  f32x2 ax; ax.x = fabsf(x.x); ax.y = fabsf(x.y);
  f32x2 z = ax * 0.70710678118654752f;
  f32x2 den = z * 0.3275911f + 1.f;
  f32x2 t; t.x = __builtin_amdgcn_rcpf(den.x); t.y = __builtin_amdgcn_rcpf(den.y);
  f32x2 poly = t * 1.061405429f + (-1.453152027f);
  poly = poly * t + 1.421413741f; poly = poly * t + (-0.284496736f); poly = poly * t + 0.254829592f; poly = poly * t;
  f32x2 ez = z * z * (-1.4426950408889634f);
  f32x2 e; e.x = __builtin_amdgcn_exp2f(ez.x); e.y = __builtin_amdgcn_exp2f(ez.y);
  f32x2 er = 1.f - poly * e;
  er.x = copysignf(er.x, x.x); er.y = copysignf(er.y, x.y);
  f32x2 hx = x * 0.5f;
  return (hx * er + hx) * g;
}
template <int NF>
__device__ __forceinline__ void conv_rows(f32x4 (&acc)[8][NF], int f, float w0, float w1, float w2, float bias, f32x4 (&out)[8]) {
  int tl_ = threadIdx.x; asm volatile("" : "+v"(tl_));
  const int l = tl_ & 63, q4 = l >> 4;
#pragma unroll
  for (int mf = 0; mf < 8; ++mf) {
    float sp = (q4 == 3) ? (mf > 0 ? acc[mf > 0 ? mf - 1 : 0][f][3] : 0.f) : acc[mf][f][3];
    float sn = (q4 == 0) ? (mf < 7 ? acc[mf < 7 ? mf + 1 : 7][f][0] : 0.f) : acc[mf][f][0];
    float prev = __shfl(sp, (l - 16) & 63);
    float next = __shfl(sn, (l + 16) & 63);
    float u0 = acc[mf][f][0], u1 = acc[mf][f][1], u2 = acc[mf][f][2], u3 = acc[mf][f][3];
    out[mf][0] = w0 * prev + w1 * u0 + w2 * u1 + bias;
    out[mf][1] = w0 * u0 + w1 * u1 + w2 * u2 + bias;
    out[mf][2] = w0 * u1 + w1 * u2 + w2 * u3 + bias;
    out[mf][3] = w0 * u2 + w1 * u3 + w2 * next + bias;
  }
}
struct EpiFfn {
  u16* H; const float* cw; const float* cb; int b, tbase, nt;
  template <int NFT, int F0>
  __device__ __forceinline__ void run(f32x4 (&acc)[8][NFT], int w) {
    int tid = threadIdx.x; asm volatile("" : "+v"(tid));
    const int l = tid & 63, c = l & 15, q4 = l >> 4;
    const int ch = nt * 128 + w * 16 + c;
    f32x4 a[8], g[8];
    conv_rows<NFT>(acc, F0, cw[ch], cw[2 * FF + ch], cw[4 * FF + ch], cb[ch], a);
    conv_rows<NFT>(acc, F0 + 1, cw[FF + ch], cw[3 * FF + ch], cw[5 * FF + ch], cb[FF + ch], g);
#pragma unroll
    for (int mf = 0; mf < 8; ++mf) {
      f32x2 h01 = gelu2_gate(f32x2{a[mf][0], a[mf][1]}, f32x2{g[mf][0], g[mf][1]});
      f32x2 h23 = gelu2_gate(f32x2{a[mf][2], a[mf][3]}, f32x2{g[mf][2], g[mf][3]});
      const bool odd = c & 1;
      const float r0 = dpp_xor1(odd ? h01.x : h23.x), r1 = dpp_xor1(odd ? h01.y : h23.y);
      const float lo0 = odd ? r0 : h01.x, hi0 = odd ? h23.x : r0;
      const float lo1 = odd ? r1 : h01.y, hi1 = odd ? h23.y : r1;
      const int rb = mf * 16 + q4 * 4 + (odd ? 2 : 0);
      const int chp = ch & ~1;
      {
        int r = rb, t = tbase + r;
        if (r >= 1 && r <= 126 && t < L) *(unsigned*)(H + ((size_t)b * L + t) * FF + chp) = cvtpk(lo0, hi0);
        r = rb + 1; t = tbase + r;
        if (r >= 1 && r <= 126 && t < L) *(unsigned*)(H + ((size_t)b * L + t) * FF + chp) = cvtpk(lo1, hi1);
      }
    }
  }
};
struct EpiHy {
  u16* VXT; u16* X0T; const float* cw; const float* cb; int b, tbase, nt;
  template <int NFT, int F0>
  __device__ __forceinline__ void run(f32x4 (&acc)[8][NFT], int w) {
    int tid = threadIdx.x; asm volatile("" : "+v"(tid));
    const int l = tid & 63, c = l & 15, q4 = l >> 4;
    const int ch = nt * 64 + w * 16 + c;
    f32x4 x0[8], x1[8], v[8];
    conv_rows<3>(acc, 0, cw[ch], cw[3072 + ch], cw[6144 + ch], cb[ch], x0);
    conv_rows<3>(acc, 1, cw[1024 + ch], cw[3072 + 1024 + ch], cw[6144 + 1024 + ch], cb[1024 + ch], x1);
    conv_rows<3>(acc, 2, cw[2048 + ch], cw[3072 + 2048 + ch], cw[6144 + 2048 + ch], cb[2048 + ch], v);
    u16* vd = VXT + ((size_t)b * 1024 + ch) * L;
    u16* xd = X0T + ((size_t)b * 1024 + ch) * L;
#pragma unroll
    for (int mf = 0; mf < 8; ++mf)
#pragma unroll
      for (int pr = 0; pr < 2; ++pr) {
        int r = mf * 16 + q4 * 4 + pr * 2; int t = tbase + r;
        if (r >= 2 && r < 126 && t < L) {
          *(unsigned*)(vd + t) = cvtpk(v[mf][pr * 2] * x1[mf][pr * 2], v[mf][pr * 2 + 1] * x1[mf][pr * 2 + 1]);
          *(unsigned*)(xd + t) = cvtpk(x0[mf][pr * 2], x0[mf][pr * 2 + 1]);
        }
      }
  }
};

__device__ __forceinline__ void phase_gemm1(const Params& p, char* smem) {
  char* ws = p.ws;
  const u16* HA = (const u16*)(ws + WS_HA);
  const u16* W = (const u16*)(ws + WS_W1T);
  const bool xs = (gridDim.x == 256);
  const int xcd = blockIdx.x & 7, jb = blockIdx.x >> 3;
  for (int tt = xs ? jb : blockIdx.x; tt < (xs ? 162 : 1296); tt += xs ? 32 : gridDim.x) {
    int pi, nt;
    if (xs) {
      if (tt < 160) { nt = tt % 10; pi = xcd * 16 + tt / 10; } else { pi = 128 + (xcd >> 1); nt = 2 + (xcd & 1) * 2 + (tt - 160); }
    } else { int idx = tt; if (idx < 1280) { nt = idx % 10; pi = idx / 10; } else { int j = idx - 1280; pi = 128 + (j >> 2); nt = 2 + (j & 3); } }
    Epi1 ep[2]; ALPlain al[2];
#pragma unroll
    for (int g = 0; g < 2; ++g) {
      int mt = 2 * pi + g;
      ep[g].ws = ws; ep[g].nt = nt;
      if (mt < 256) { ep[g].ctx = false; ep[g].b = mt >> 6; ep[g].t0 = (mt & 63) * 128; }
      else { ep[g].ctx = true; ep[g].b = (mt - 256) >> 1; ep[g].t0 = ((mt - 256) & 1) * 128; }
      al[g].base = HA + (size_t)mt * 128 * D; al[g].lda = D;
    }
    gemm_tile2<4>(smem, al[0], al[1], W + (size_t)nt * 256 * D, D, ep[0], ep[1]);
  }
}
template <int AMODE>
__device__ __forceinline__ void phase_gemm_res(const Params& p, char* smem, const u16* A, int K, const u16* Wt, const float* Xf, const u16* X16, u16* R, int gate_layer, int gate_off) {
  char* ws = p.ws;
  const bool xs = (gridDim.x == 256);
  const int xcd = blockIdx.x & 7, jb = blockIdx.x >> 3;
  for (int tt = xs ? jb : blockIdx.x; tt < (xs ? 64 : 512); tt += xs ? 32 : gridDim.x) {
    int idx = xs ? xcd * 64 + tt : tt;
    int nt = idx & 3, pi = idx >> 2;
    int b = pi >> 5;
    EpiRes ep[2];
#pragma unroll
    for (int g = 0; g < 2; ++g) {
      ep[g].Xf = Xf; ep[g].X16 = X16; ep[g].R = R; ep[g].m0 = (2 * pi + g) * 128; ep[g].n0 = nt * 256;
      ep[g].gate = (const float*)(ws + WS_MODV) + ((size_t)gate_layer * 5 + b) * NMOD + gate_off;
    }
    const u16* Bt = Wt + (size_t)nt * 256 * K;
    if (AMODE == 0) {
      ALPlain al[2];
#pragma unroll
      for (int g = 0; g < 2; ++g) { al[g].base = A + (size_t)(2 * pi + g) * 128 * K; al[g].lda = K; }
      gemm_tile2<4>(smem, al[0], al[1], Bt, K, ep[0], ep[1], p.flags);
    } else if (AMODE == 1) {
      ALCat al[2];
#pragma unroll
      for (int g = 0; g < 2; ++g) {
        int mt = 2 * pi + g; int t0 = (mt & 63) * 128;
        al[g].obase = (const u16*)(ws + WS_O) + (size_t)mt * 128 * 512; al[g].ybase = (const u16*)(ws + WS_YT) + (size_t)b * 512 * L + t0; al[g].last = 0;
      }
      gemm_tile2<4>(smem, al[0], al[1], Bt, K, ep[0], ep[1]);
    } else {
      ALTrans al[2];
#pragma unroll
      for (int g = 0; g < 2; ++g) { int mt = 2 * pi + g; int t0 = (mt & 63) * 128; al[g].base = A + (size_t)b * 1024 * L + t0; }
      gemm_tile2<4>(smem, al[0], al[1], Bt, K, ep[0], ep[1]);
    }
  }
}
__device__ __forceinline__ void phase_gemm_ffn_in(const Params& p, char* smem, int layer) {
  char* ws = p.ws;
  const u16* HA = (const u16*)(ws + WS_HA);
  const u16* W = (const u16*)(ws + WS_W3T) + (size_t)layer * 5632 * 1024;
  const bool xs = (gridDim.x == 256);
  const int xcd = blockIdx.x & 7, jb = blockIdx.x >> 3;
  for (int tt = xs ? jb : blockIdx.x; tt < (xs ? 363 : 132 * 22); tt += xs ? 32 : gridDim.x) {
    int nt, pi;
    if (xs) { pi = (xcd & 3) * 33 + tt / 11; nt = (xcd >> 2) * 11 + tt % 11; }
    else { nt = tt % 22; pi = tt / 22; }
    int b = pi / 33;
    EpiFfn ep[2]; ALHalo al[2];
#pragma unroll
    for (int g = 0; g < 2; ++g) {
      int i = (2 * pi + g) - b * 66;
      ep[g].H = (u16*)(ws + WS_H); ep[g].cw = p.in[11] + (size_t)layer * 3 * 2 * FF; ep[g].cb = p.in[12] + (size_t)layer * 2 * FF;
      ep[g].b = b; ep[g].tbase = 126 * i - 1; ep[g].nt = nt;
      al[g].wsb = ws; al[g].hoff = (unsigned)(WS_HA + (size_t)b * L * D * 2); al[g].t0 = ep[g].tbase;
    }
    gemm_tile2<4>(smem, al[0], al[1], W + (size_t)nt * 256 * D, D, ep[0], ep[1], p.flags);
  }
}
__device__ __forceinline__ void phase_gemm_hy_in(const Params& p, char* smem) {
  char* ws = p.ws;
  const u16* W = (const u16*)(ws + WS_W5T);
  const bool xs = (gridDim.x == 256);
  const int xcd = blockIdx.x & 7, jb = blockIdx.x >> 3;
  for (int tt = xs ? jb : blockIdx.x; tt < (xs ? 272 : 136 * 16); tt += xs ? 32 : gridDim.x) {
    int nt, pi;
    if (xs) { pi = (xcd & 3) * 34 + (tt >> 3); nt = (xcd >> 2) * 8 + (tt & 7); }
    else { nt = tt & 15; pi = tt >> 4; }
    int b = pi / 34;
    EpiHy ep[2]; ALHalo al[2];
#pragma unroll
    for (int g = 0; g < 2; ++g) {
      int i = (2 * pi + g) - b * 68;
      ep[g].VXT = (u16*)(ws + WS_VXT); ep[g].X0T = (u16*)(ws + WS_X0T); ep[g].cw = p.in[22]; ep[g].cb = p.in[23];
      ep[g].b = b; ep[g].tbase = 124 * i - 2; ep[g].nt = nt;
      al[g].wsb = ws; al[g].hoff = (unsigned)(WS_HA + (size_t)b * L * D * 2); al[g].t0 = ep[g].tbase;
    }
    gemm_tile2<3>(smem, al[0], al[1], W + (size_t)nt * 192 * D, D, ep[0], ep[1], p.flags);
  }
}

__device__ __forceinline__ void ln_norm(float (&v)[16]) {
  float s = 0.f;
#pragma unroll
  for (int i = 0; i < 16; ++i) s += v[i];
  const float mu = wave_sum(s) * (1.f / D);
  float q = 0.f;
#pragma unroll
  for (int i = 0; i < 16; ++i) { v[i] -= mu; q += v[i] * v[i]; }
  const float rs = rsqrtf(wave_sum(q) * (1.f / D) + LN_EPS);
#pragma unroll
  for (int i = 0; i < 16; ++i) v[i] *= rs;
}
__device__ __forceinline__ void ld8f(const float* p, float* o) {
  float4 a = *(const float4*)p, b = *(const float4*)(p + 4);
  o[0] = a.x; o[1] = a.y; o[2] = a.z; o[3] = a.w; o[4] = b.x; o[5] = b.y; o[6] = b.z; o[7] = b.w;
}
struct LnPar { float g[16], b[16]; };
__device__ __forceinline__ void ln_row(float (&v)[16], const LnPar* par, float* dstf, u16* dst16,
                                       const float* shift, const float* scale, u16* dsth) {
  const int l = threadIdx.x & 63;
  if (par) {
    ln_norm(v);
#pragma unroll
    for (int h = 0; h < 2; ++h) {
#pragma unroll
      for (int e = 0; e < 8; ++e) v[h * 8 + e] = v[h * 8 + e] * par->g[h * 8 + e] + par->b[h * 8 + e];
      if (dstf) {
        *(float4*)(dstf + h * 512 + l * 8) = make_float4(v[h * 8], v[h * 8 + 1], v[h * 8 + 2], v[h * 8 + 3]);
        *(float4*)(dstf + h * 512 + l * 8 + 4) = make_float4(v[h * 8 + 4], v[h * 8 + 5], v[h * 8 + 6], v[h * 8 + 7]);
      }
      if (dst16) *(uint4*)(dst16 + h * 512 + l * 8) = make_uint4(cvtpk(v[h * 8], v[h * 8 + 1]), cvtpk(v[h * 8 + 2], v[h * 8 + 3]), cvtpk(v[h * 8 + 4], v[h * 8 + 5]), cvtpk(v[h * 8 + 6], v[h * 8 + 7]));
    }
  }
  if (dsth) {
    ln_norm(v);
#pragma unroll
    for (int h = 0; h < 2; ++h) {
      float sc[8], sh[8]; ld8f(scale + h * 512 + l * 8, sc); ld8f(shift + h * 512 + l * 8, sh);
      float o[8];
#pragma unroll
      for (int e = 0; e < 8; ++e) o[e] = v[h * 8 + e] * (1.f + sc[e]) + sh[e];
      *(uint4*)(dsth + h * 512 + l * 8) = make_uint4(cvtpk(o[0], o[1]), cvtpk(o[2], o[3]), cvtpk(o[4], o[5]), cvtpk(o[6], o[7]));
    }
  }
}
__device__ __forceinline__ void phase_ln(const Params& p, const float* srcf, const u16* src16, const float* lg, const float* lb, float* dstf, u16* dst16,
                         int mod_layer, int shift_off, int scale_off, bool do_mod, bool with_ctx) {
  char* ws = p.ws;
  const int wg = blockIdx.x * 8 + (threadIdx.x >> 6), nw = gridDim.x * 8, l = threadIdx.x & 63;
  u16* HA = (u16*)(ws + WS_HA);
  const float* modv = (const float*)(ws + WS_MODV) + (size_t)mod_layer * 5 * NMOD;
  const int nrows = with_ctx ? M + NB * LC : M;
  LnPar par;
  if (lg) {
#pragma unroll
    for (int h = 0; h < 2; ++h) { ld8f(lg + h * 512 + l * 8, par.g + h * 8); ld8f(lb + h * 512 + l * 8, par.b + h * 8); }
  }
  auto loadrow = [&](int row, float (&v)[16]) {
    if (row < M && src16) {
#pragma unroll
      for (int h = 0; h < 2; ++h) {
        uint4 t = *(const uint4*)(src16 + (size_t)row * D + h * 512 + l * 8);
        v[h * 8] = bflo(t.x); v[h * 8 + 1] = bfhi(t.x); v[h * 8 + 2] = bflo(t.y); v[h * 8 + 3] = bfhi(t.y);
        v[h * 8 + 4] = bflo(t.z); v[h * 8 + 5] = bfhi(t.z); v[h * 8 + 6] = bflo(t.w); v[h * 8 + 7] = bfhi(t.w);
      }
    } else {
      const float* sp = (row < M) ? srcf + (size_t)row * D : p.in[2] + (size_t)(row - M) * D;
#pragma unroll
      for (int h = 0; h < 2; ++h) ld8f(sp + h * 512 + l * 8, v + h * 8);
    }
  };
  auto dorow = [&](int row, float (&v)[16]) {
    if (row < M) {
      int b = row >> 13;
      ln_row(v, lg ? &par : nullptr, dstf ? dstf + (size_t)row * D : nullptr, dst16 ? dst16 + (size_t)row * D : nullptr,
             modv + (size_t)b * NMOD + shift_off, modv + (size_t)b * NMOD + scale_off, do_mod ? HA + (size_t)row * D : nullptr);
    } else {
      ln_row(v, nullptr, nullptr, nullptr,
             modv + (size_t)4 * NMOD + shift_off, modv + (size_t)4 * NMOD + scale_off, HA + (size_t)row * D);
    }
  };
  for (int row = wg; row < nrows; row += 2 * nw) {
    float v0[16], v1[16];
    const int row1 = row + nw;
    loadrow(row, v0);
    if (row1 < nrows) loadrow(row1, v1);
    dorow(row, v0);
    if (row1 < nrows) dorow(row1, v1);
  }
}

__device__ __forceinline__ int swap23(int x) { return (x & ~12) | ((x & 4) << 1) | ((x & 8) >> 1); }
__device__ __forceinline__ void attn_unit(const Params& p, char* smem, int b, int h, int qb) {
  char* ws = p.ws;
  const int tid = threadIdx.x, w = tid >> 6, l = tid & 63, comp = w >> 2, qf = w & 3, r32 = l & 31, hh = l >> 5;
  const int wvb = __builtin_amdgcn_readfirstlane((tid >> 6) << 10);
  const int bh = b * 4 + h;
  const u16* Qg = (const u16*)(ws + WS_Q) + ((size_t)(bh * 2 + comp) * L + qb * 128 + qf * 32 + r32) * 64;
  bf16x8 qfrag[4];
#pragma unroll
  for (int s = 0; s < 4; ++s) qfrag[s] = *(const bf16x8*)(Qg + 16 * s + 8 * hh);
  const int prow = tid >> 3, pc = tid & 7;
  const unsigned koff = (unsigned)(swap23(prow) * 128 + ((pc ^ ((prow >> 1) & 7)) << 4));
  const unsigned k1base = (unsigned)(WS_K + (size_t)(bh * 2) * LK * 128) + koff;
  const unsigned k2base = k1base + (unsigned)(LK * 128);
  const unsigned vbase = (unsigned)(WS_VT + (size_t)bh * 128 * LK * 2) + (unsigned)prow * (LK * 2) + ((pc ^ ((prow >> 1) & 7)) << 4);
  auto issueT = [&](int it) {
    char* slot = smem + (it & 3) * 32768 + wvb;
    glds16u(ws, k1base + (unsigned)it * 8192u, slot);
    glds16u(ws, k2base + (unsigned)it * 8192u, slot + 8192);
    glds16u(ws, vbase + (unsigned)it * 128u, slot + 16384);
    glds16u(ws, vbase + (unsigned)it * 128u + 64u * (LK * 2), slot + 24576);
  };
  f32x16 o[4];
#pragma unroll
  for (int i = 0; i < 4; ++i)
#pragma unroll
    for (int j = 0; j < 16; ++j) o[i][j] = 0.f;
  float mrun = 0.f, lsum = 0.f;
  constexpr int NIT = LK / 64;
  constexpr float THR = 8.f;
  auto qk = [&](f32x16& s0, f32x16& s1, int it, float init) {
    const char* Kb = smem + (it & 3) * 32768 + comp * 8192;
    bf16x8 a0[4], a1[4];
#pragma unroll
    for (int s = 0; s < 4; ++s) { a0[s] = *(const bf16x8*)(Kb + swz16(r32, 2 * s + hh)); a1[s] = *(const bf16x8*)(Kb + swz16(32 + r32, 2 * s + hh)); }
#pragma unroll
    for (int j = 0; j < 16; ++j) { s0[j] = init; s1[j] = init; }
#pragma unroll
    for (int s = 0; s < 4; ++s) {
      s0 = __builtin_amdgcn_mfma_f32_32x32x16_bf16(a0[s], qfrag[s], s0, 0, 0, 0);
      s1 = __builtin_amdgcn_mfma_f32_32x32x16_bf16(a1[s], qfrag[s], s1, 0, 0, 0);
    }
  };
#define ABAR() do { __builtin_amdgcn_s_barrier(); asm volatile("" ::: "memory"); } while (0)
  bf16x8 pb[2][2];
  auto half1 = [&](f32x16& c0, f32x16& c1, f32x16& n0, f32x16& n1, int it) {
    if (comp == 1 && it + 3 < NIT) issueT(it + 3);
    float mx = c0[0];
#pragma unroll
    for (int j = 1; j < 16; ++j) mx = fmaxf(mx, c0[j]);
#pragma unroll
    for (int j = 0; j < 16; ++j) mx = fmaxf(mx, c1[j]);
    { auto rr = __builtin_amdgcn_permlane32_swap(__float_as_uint(mx), __float_as_uint(mx), false, false);
      mx = fmaxf(__uint_as_float(rr[0]), __uint_as_float(rr[1])); }
    if (__builtin_expect(__any((mx > THR) || (it == 0)), 0)) {
      const float d = (it == 0) ? mx : fmaxf(mx, 0.f);
      const float al = __builtin_amdgcn_exp2f(-d);
      mrun += d; lsum *= al;
#pragma unroll
      for (int j = 0; j < 16; ++j) { c0[j] -= d; c1[j] -= d; }
#pragma unroll
      for (int i = 0; i < 4; ++i)
#pragma unroll
        for (int j = 0; j < 16; ++j) o[i][j] *= al;
    }
    if (it + 1 < NIT) qk(n0, n1, it + 1, -mrun);
    float ps = 0.f;
#pragma unroll
    for (int j = 0; j < 16; ++j) { c0[j] = __builtin_amdgcn_exp2f(c0[j]); ps += c0[j]; }
#pragma unroll
    for (int j = 0; j < 16; ++j) { c1[j] = __builtin_amdgcn_exp2f(c1[j]); ps += c1[j]; }
    lsum += ps;
#pragma unroll
    for (int s2 = 0; s2 < 2; ++s2) {
      uint4 u = make_uint4(cvtpk(c0[8 * s2], c0[8 * s2 + 1]), cvtpk(c0[8 * s2 + 2], c0[8 * s2 + 3]), cvtpk(c0[8 * s2 + 4], c0[8 * s2 + 5]), cvtpk(c0[8 * s2 + 6], c0[8 * s2 + 7]));
      pb[0][s2] = *(bf16x8*)&u;
      uint4 u2 = make_uint4(cvtpk(c1[8 * s2], c1[8 * s2 + 1]), cvtpk(c1[8 * s2 + 2], c1[8 * s2 + 3]), cvtpk(c1[8 * s2 + 4], c1[8 * s2 + 5]), cvtpk(c1[8 * s2 + 6], c1[8 * s2 + 7]));
      pb[1][s2] = *(bf16x8*)&u2;
    }
#pragma unroll
    for (int g = 0; g < 8; ++g) { __builtin_amdgcn_sched_group_barrier(0x008, 1, 0); __builtin_amdgcn_sched_group_barrier(0x002, 12, 0); }
    if (comp == 1) {
      if (it + 3 < NIT) asm volatile("s_waitcnt vmcnt(4) lgkmcnt(0)" ::: "memory");
      else asm volatile("s_waitcnt vmcnt(0) lgkmcnt(0)" ::: "memory");
    } else asm volatile("s_waitcnt lgkmcnt(0)" ::: "memory");
    ABAR();
  };
  auto half2 = [&](int it) {
    if (comp == 0 && it + 3 < NIT) issueT(it + 3);
    const char* Vb = smem + (it & 3) * 32768 + 16384;
    bf16x8 va[4], vb2[4];
    auto rdV = [&](bf16x8 (&v)[4], int k) {
#pragma unroll
      for (int ef = 0; ef < 4; ++ef) v[ef] = *(const bf16x8*)(Vb + swz16(ef * 32 + r32, 2 * k + hh));
    };
    rdV(va, 0); rdV(vb2, 1); SB();
#pragma unroll
    for (int ef = 0; ef < 4; ++ef) o[ef] = __builtin_amdgcn_mfma_f32_32x32x16_bf16(va[ef], pb[0][0], o[ef], 0, 0, 0);
    SB(); rdV(va, 2); SB();
#pragma unroll
    for (int ef = 0; ef < 4; ++ef) o[ef] = __builtin_amdgcn_mfma_f32_32x32x16_bf16(vb2[ef], pb[0][1], o[ef], 0, 0, 0);
    SB(); rdV(vb2, 3); SB();
#pragma unroll
    for (int ef = 0; ef < 4; ++ef) o[ef] = __builtin_amdgcn_mfma_f32_32x32x16_bf16(va[ef], pb[1][0], o[ef], 0, 0, 0);
    SB();
#pragma unroll
    for (int ef = 0; ef < 4; ++ef) o[ef] = __builtin_amdgcn_mfma_f32_32x32x16_bf16(vb2[ef], pb[1][1], o[ef], 0, 0, 0);
    if (comp == 0) {
      if (it + 3 < NIT) asm volatile("s_waitcnt vmcnt(4) lgkmcnt(0)" ::: "memory");
      else asm volatile("s_waitcnt vmcnt(0) lgkmcnt(0)" ::: "memory");
    } else asm volatile("s_waitcnt lgkmcnt(0)" ::: "memory");
    ABAR();
  };
  issueT(0); issueT(1); issueT(2);
  asm volatile("s_waitcnt vmcnt(0) lgkmcnt(0)" ::: "memory");
  ABAR();
  f32x16 sa0, sa1, sb0, sb1;
  qk(sa0, sa1, 0, 0.f);
  if (comp == 1) { asm volatile("s_waitcnt lgkmcnt(0)" ::: "memory"); ABAR(); }
  for (int it = 0; it < NIT; it += 2) {
    half1(sa0, sa1, sb0, sb1, it);
    half2(it);
    half1(sb0, sb1, sa0, sa1, it + 1);
    half2(it + 1);
  }
  if (comp == 0) ABAR();
  __syncthreads();
  float ltot = lsum + swap32_f(lsum);
  float inv = 1.f / ltot;
  float* X = (float*)smem;
  if (comp == 1) {
#pragma unroll
    for (int ef = 0; ef < 4; ++ef)
#pragma unroll
      for (int j = 0; j < 16; ++j) {
        int e = ef * 32 + (j & 3) + 8 * (j >> 2) + 4 * hh;
        X[(qf * 128 + e) * 32 + r32] = o[ef][j] * inv;
      }
  }
  __syncthreads();
  if (comp == 0) {
    const float lam = *(const float*)(ws + WS_MISC);
    float ss = 0.f;
#pragma unroll
    for (int ef = 0; ef < 4; ++ef)
#pragma unroll
      for (int j = 0; j < 16; ++j) {
        int e = ef * 32 + (j & 3) + 8 * (j >> 2) + 4 * hh;
        float val = o[ef][j] * inv - lam * X[(qf * 128 + e) * 32 + r32];
        o[ef][j] = val; ss += val * val;
      }
    ss += swap32_f(ss);
    float rms = rsqrtf(ss * (1.f / 128.f) + LN_EPS) * 0.8f;
    const float* sg = p.in[20];
    u16* dst = (u16*)(ws + WS_O) + ((size_t)b * L + qb * 128 + qf * 32 + r32) * 512 + h * 128;
#pragma unroll
    for (int ef = 0; ef < 4; ++ef)
#pragma unroll
      for (int jg = 0; jg < 4; ++jg) {
        int e = ef * 32 + 8 * jg + 4 * hh;
        float4 g = *(const float4*)(sg + e);
        uint2 ov;
        ov.x = cvtpk(o[ef][4 * jg] * rms * g.x, o[ef][4 * jg + 1] * rms * g.y);
        ov.y = cvtpk(o[ef][4 * jg + 2] * rms * g.z, o[ef][4 * jg + 3] * rms * g.w);
        *(uint2*)(dst + e) = ov;
      }
  }
  __syncthreads();
}

__device__ __forceinline__ float2 cmul(float2 a, float2 b) { return make_float2(a.x * b.x - a.y * b.y, a.x * b.y + a.y * b.x); }
__device__ __forceinline__ float2 twid(float frac) {
  return make_float2(__builtin_amdgcn_cosf(frac), -__builtin_amdgcn_sinf(frac));
}
template <int N>
__device__ __forceinline__ void fft_fwd(float2* s) {
  const int tid = threadIdx.x;
  constexpr int LOGN = (N == 8192) ? 13 : 14;
  int Ns = N;
  if (LOGN & 1) {
    constexpr int H = N / 2;
    for (int j = tid; j < H; j += NTH) {
      float2 a = s[j], b = s[j + H];
      float2 wv = twid((float)j * (1.f / N));
      s[j] = make_float2(a.x + b.x, a.y + b.y);
      s[j + H] = cmul(make_float2(a.x - b.x, a.y - b.y), wv);
    }
    Ns = H;
    __syncthreads();
  }
  for (; Ns >= 4; Ns >>= 2) {
    const int q = Ns >> 2;
    const int lq = 31 - __builtin_clz(q);
    const float invNs = 1.f / (float)Ns;
#pragma unroll 2
    for (int idx = tid; idx < N / 4; idx += NTH) {
      int g = idx >> lq, j = idx & (q - 1); int base = g * Ns + j;
      float2 a0 = s[base], a1 = s[base + q], a2 = s[base + 2 * q], a3 = s[base + 3 * q];
      float2 w1 = twid((float)j * invNs), w2 = cmul(w1, w1), w3 = cmul(w2, w1);
      float2 t0 = make_float2(a0.x + a2.x, a0.y + a2.y), t1 = make_float2(a0.x - a2.x, a0.y - a2.y);
      float2 t2 = make_float2(a1.x + a3.x, a1.y + a3.y), t3 = make_float2(a1.x - a3.x, a1.y - a3.y);
      float2 b0 = make_float2(t0.x + t2.x, t0.y + t2.y);
      float2 b2 = make_float2(t0.x - t2.x, t0.y - t2.y);
      float2 b1 = make_float2(t1.x + t3.y, t1.y - t3.x);
      float2 b3 = make_float2(t1.x - t3.y, t1.y + t3.x);
      s[base] = b0; s[base + q] = cmul(b1, w1); s[base + 2 * q] = cmul(b2, w2); s[base + 3 * q] = cmul(b3, w3);
    }
    __syncthreads();
  }
}
template <int N>
__device__ __forceinline__ void fft_inv(float2* s) {
  const int tid = threadIdx.x;
  for (int Ns = 4; Ns <= N; Ns <<= 2) {
    const int q = Ns >> 2;
    const int lq = 31 - __builtin_clz(q);
    const float invNs = 1.f / (float)Ns;
#pragma unroll 2
    for (int idx = tid; idx < N / 4; idx += NTH) {
      int g = idx >> lq, j = idx & (q - 1); int base = g * Ns + j;
      float2 w1 = twid((float)j * invNs); w1.y = -w1.y;
      float2 w2 = cmul(w1, w1), w3 = cmul(w2, w1);
      float2 a0 = s[base], a1 = cmul(s[base + q], w1), a2 = cmul(s[base + 2 * q], w2), a3 = cmul(s[base + 3 * q], w3);
      float2 t0 = make_float2(a0.x + a2.x, a0.y + a2.y), t1 = make_float2(a0.x - a2.x, a0.y - a2.y);
      float2 t2 = make_float2(a1.x + a3.x, a1.y + a3.y), t3 = make_float2(a1.x - a3.x, a1.y - a3.y);
      s[base] = make_float2(t0.x + t2.x, t0.y + t2.y);
      s[base + 2 * q] = make_float2(t0.x - t2.x, t0.y - t2.y);
      s[base + q] = make_float2(t1.x - t3.y, t1.y + t3.x);
      s[base + 3 * q] = make_float2(t1.x + t3.y, t1.y - t3.x);
    }
    __syncthreads();
  }
}

__device__ __forceinline__ void fourier_unit(const Params& p, char* smem, int unit) {
  char* ws = p.ws;
  float2* s = (float2*)smem;
  const int tid = threadIdx.x;
  const unsigned* src = (const unsigned*)(ws + WS_FZ) + (size_t)unit * L;
  for (int t = tid * 4; t < L; t += NTH * 4) {
    uint4 v = *(const uint4*)(src + t);
    s[t] = make_float2(bflo(v.x), bfhi(v.x)); s[t + 1] = make_float2(bflo(v.y), bfhi(v.y));
    s[t + 2] = make_float2(bflo(v.z), bfhi(v.z)); s[t + 3] = make_float2(bflo(v.w), bfhi(v.w));
  }
  __syncthreads();
  fft_fwd<8192>(s);
  u16* dst = (u16*)(ws + WS_YT) + (size_t)unit * L;
  for (int k0 = tid * 2; k0 < L; k0 += NTH * 2) {
    float v[2];
#pragma unroll
    for (int i = 0; i < 2; ++i) {
      int k = k0 + i; int m1 = k & 1; int k1 = k >> 1;
      int pp = (m1 << 12) | ((k1 & 3) << 10) | (((k1 >> 2) & 3) << 8) | (((k1 >> 4) & 3) << 6) | (((k1 >> 6) & 3) << 4) | (((k1 >> 8) & 3) << 2) | ((k1 >> 10) & 3);
      v[i] = s[pp].x * (1.f / 1024.f);
    }
    *(unsigned*)(dst + k0) = cvtpk(v[0], v[1]);
  }
  __syncthreads();
}

__device__ __forceinline__ void phase_attn_fourier(const Params& p, char* smem) {
  if (gridDim.x == 256) {
    const int xcd = blockIdx.x & 7, j = blockIdx.x >> 3;
    for (int i = 0; i < 4; ++i) {
      int local = j + 32 * i; int pair = 2 * xcd + (local >> 6), qb = local & 63;
      attn_unit(p, smem, pair >> 2, pair & 3, qb);
    }
  } else {
    for (int u = blockIdx.x; u < 1024; u += gridDim.x) attn_unit(p, smem, u >> 8, (u >> 6) & 3, u & 63);
  }
  for (int u = blockIdx.x; u < NB * 512; u += gridDim.x) fourier_unit(p, smem, u);
}

__device__ __forceinline__ void phase_hyena_fft(const Params& p, char* smem) {
  char* ws = p.ws;
  float2* s = (float2*)smem;
  float* red = (float*)(smem + 131072);
  const int tid = threadIdx.x;
  constexpr int N = 16384;
  const float* HT = (const float*)(ws + WS_HT);
  const u16* VXT = (const u16*)(ws + WS_VXT);
  const u16* X0T = (const u16*)(ws + WS_X0T);
  u16* GT = (u16*)(ws + WS_GT);
  for (int c = blockIdx.x; c < 1024; c += gridDim.x) {
    const float* hf = HT + (size_t)c * L;
    const float* hb = HT + (size_t)(1024 + c) * L;
    float l1 = 0.f;
    for (int n = tid; n < N; n += NTH) {
      float v = (n < L) ? hf[n] : ((n == L) ? 0.f : hb[N - n]);
      s[n] = make_float2(v, 0.f); l1 += fabsf(v);
    }
    l1 = wave_sum(l1);
    if ((tid & 63) == 0) red[tid >> 6] = l1;
    __syncthreads();
    float tot = 0.f;
#pragma unroll
    for (int i = 0; i < 8; ++i) tot += red[i];
    fft_fwd<N>(s);
    const float scale = 1.f / (tot * (float)N);
    float2* kspec = (float2*)(ws + WS_KSPEC) + (size_t)blockIdx.x * N;
#pragma unroll 4
    for (int i = 0; i < 32; ++i) { float2 v = s[tid + NTH * i]; kspec[tid + NTH * i] = make_float2(v.x * scale, v.y * scale); }
    __syncthreads();
    const float dsk = p.in[32][c];
#pragma unroll 1
    for (int pair = 0; pair < 2; ++pair) {
      const u16* v0 = VXT + ((size_t)(2 * pair) * 1024 + c) * L;
      const u16* v1 = VXT + ((size_t)(2 * pair + 1) * 1024 + c) * L;
      for (int t = tid * 8; t < L; t += NTH * 8) {
        uint4 a = *(const uint4*)(v0 + t), bq = *(const uint4*)(v1 + t);
        s[t] = make_float2(bflo(a.x), bflo(bq.x)); s[t + 1] = make_float2(bfhi(a.x), bfhi(bq.x));
        s[t + 2] = make_float2(bflo(a.y), bflo(bq.y)); s[t + 3] = make_float2(bfhi(a.y), bfhi(bq.y));
        s[t + 4] = make_float2(bflo(a.z), bflo(bq.z)); s[t + 5] = make_float2(bfhi(a.z), bfhi(bq.z));
        s[t + 6] = make_float2(bflo(a.w), bflo(bq.w)); s[t + 7] = make_float2(bfhi(a.w), bfhi(bq.w));
      }
      for (int t = L + tid; t < N; t += NTH) s[t] = make_float2(0.f, 0.f);
      __syncthreads();
      fft_fwd<N>(s);
#pragma unroll 4
      for (int i = 0; i < 32; ++i) { int pp = tid + NTH * i; s[pp] = cmul(s[pp], kspec[pp]); }
      __syncthreads();
      fft_inv<N>(s);
      const u16* x0a = X0T + ((size_t)(2 * pair) * 1024 + c) * L;
      const u16* x0b = X0T + ((size_t)(2 * pair + 1) * 1024 + c) * L;
      u16* g0 = GT + ((size_t)(2 * pair) * 1024 + c) * L;
      u16* g1 = GT + ((size_t)(2 * pair + 1) * 1024 + c) * L;
      for (int t = tid * 2; t < L; t += NTH * 2) {
        unsigned va = *(const unsigned*)(v0 + t), vb = *(const unsigned*)(v1 + t);
        unsigned xa = *(const unsigned*)(x0a + t), xb = *(const unsigned*)(x0b + t);
        float2 y0 = s[t], y1 = s[t + 1];
        *(unsigned*)(g0 + t) = cvtpk((y0.x + bflo(va) * dsk) * bflo(xa), (y1.x + bfhi(va) * dsk) * bfhi(xa));
        *(unsigned*)(g1 + t) = cvtpk((y0.y + bflo(vb) * dsk) * bflo(xb), (y1.y + bfhi(vb) * dsk) * bfhi(xb));
      }
      __syncthreads();
    }
  }
}

template <int MAP>
__device__ __forceinline__ int orig_col(int n) {
  if (MAP == 0) return n;
  if (MAP == 1) { int f = (n >> 4) & 1; int ch = (n >> 8) * 128 + ((n >> 5) & 7) * 16 + (n & 15); return f * FF + ch; }
  { int nt = n / 192, rem = n - nt * 192; int wv = rem / 48, r2 = rem - wv * 48; int f = r2 >> 4; int ch = nt * 64 + wv * 16 + (r2 & 15); return f * 1024 + ch; }
}
template <int MAP>
__device__ __forceinline__ void transpose_tile(const float* W, int ldw, u16* Wt, int K, int k0, int n0, float* tl) {
  const int tid = threadIdx.x;
#pragma unroll
  for (int i = 0; i < 8; ++i) {
    int idx = tid + NTH * i; int kk = idx >> 6, nn = idx & 63;
    tl[nn * 65 + kk] = W[(size_t)(k0 + kk) * ldw + orig_col<MAP>(n0 + nn)];
  }
  __syncthreads();
#pragma unroll
  for (int i = 0; i < 8; ++i) {
    int idx = tid + NTH * i; int nn = idx >> 6, kk = idx & 63;
    Wt[(size_t)(n0 + nn) * K + k0 + kk] = f2bf(tl[nn * 65 + kk]);
  }
  __syncthreads();
}

__device__ __forceinline__ void phase_prep(const Params& p, char* smem) {
  char* ws = p.ws;
  const int tid = threadIdx.x;
  float* tl = (float*)smem;
  constexpr int T_W1 = 16 * 24, T_W2 = 256, T_W3 = 16 * 88, T_W4 = 44 * 16, T_W5 = 16 * 48, T_W6 = 256;
  constexpr int O_W1 = 0, O_W2 = O_W1 + T_W1, O_W3 = O_W2 + T_W2, O_W4 = O_W3 + 2 * T_W3, O_W5 = O_W4 + 2 * T_W4, O_W6 = O_W5 + T_W5;
  constexpr int O_FOLD = O_W6 + T_W6, O_MOD = O_FOLD + 256, O_HY = O_MOD + 192, O_MISC = O_HY + 256, O_END = O_MISC + 1;
  for (int item = blockIdx.x; item < O_END; item += gridDim.x) {
    if (item < O_W2) { int j = item - O_W1; transpose_tile<0>(p.in[14], 2048, (u16*)(ws + WS_W1T), 1024, (j & 15) * 64, (j >> 4) * 64, tl); }
    else if (item < O_W3) { int j = item - O_W2; transpose_tile<0>(p.in[15], 1024, (u16*)(ws + WS_W2T), 1024, (j & 15) * 64, (j >> 4) * 64, tl); }
    else if (item < O_W4) { int j = item - O_W3; int layer = j / T_W3; j -= layer * T_W3;
      transpose_tile<1>(p.in[10] + (size_t)layer * 1024 * 5632, 5632, (u16*)(ws + WS_W3T) + (size_t)layer * 5632 * 1024, 1024, (j & 15) * 64, (j >> 4) * 64, tl); }
    else if (item < O_W5) { int j = item - O_W4; int layer = j / T_W4; j -= layer * T_W4;
      transpose_tile<0>(p.in[13] + (size_t)layer * 2816 * 1024, 1024, (u16*)(ws + WS_W4T) + (size_t)layer * 1024 * 2816, 2816, (j % 44) * 64, (j / 44) * 64, tl); }
    else if (item < O_W6) { int j = item - O_W5; transpose_tile<2>(p.in[21], 3072, (u16*)(ws + WS_W5T), 1024, (j & 15) * 64, (j >> 4) * 64, tl); }
    else if (item < O_FOLD) { int j = item - O_W6; transpose_tile<0>(p.in[33], 1024, (u16*)(ws + WS_W6T), 1024, (j & 15) * 64, (j >> 4) * 64, tl); }
    else if (item < O_MOD) {
      int j = item - O_FOLD; int g = j >> 6, k0 = (j & 63) * 16;
      float* wl = tl;
      float* cs = tl + 2048;
      for (int i = tid; i < 2048; i += NTH) { int kk = i >> 7, cc = i & 127; wl[i] = p.in[14][(size_t)(k0 + kk) * 2048 + 1536 + g * 128 + cc]; }
      if (tid < 128) { float sv, cv; sincospif((float)tid * (1.f / 64.f), &sv, &cv); cs[tid] = cv; cs[128 + tid] = sv; }
      __syncthreads();
      {
        int m = tid & 127, fsel = (tid >> 7) & 1, kh = tid >> 8;
        float accv[8];
#pragma unroll
        for (int i = 0; i < 8; ++i) accv[i] = 0.f;
        for (int cc = 0; cc < 128; ++cc) {
          float tw = fsel ? -cs[128 + ((m * cc) & 127)] : cs[(m * cc) & 127];
#pragma unroll
          for (int i = 0; i < 8; ++i) accv[i] += wl[(kh * 8 + i) * 128 + cc] * tw;
        }
        int ch = g * 128 + m;
        int nprime = 1536 + (ch >> 7) * 256 + ((ch >> 4) & 7) * 32 + fsel * 16 + (ch & 15);
        u16* dst = (u16*)(ws + WS_W1T) + (size_t)nprime * 1024 + k0 + kh * 8;
        uint4 ov; ov.x = cvtpk(accv[0], accv[1]); ov.y = cvtpk(accv[2], accv[3]); ov.z = cvtpk(accv[4], accv[5]); ov.w = cvtpk(accv[6], accv[7]);
        *(uint4*)dst = ov;
      }
      __syncthreads();
    }
    else if (item < O_HY) {
      int j = item - O_MOD; int layer = j / 96, n0 = (j % 96) * 64;
      float* sv = tl;
      float* red = tl + 5 * 1024;
      for (int i = tid; i < 5 * 1024; i += NTH) {
        int v = i >> 10, k = i & 1023;
        float x = (v < 4) ? p.in[1][v * 1024 + k] : p.in[3][k];
        sv[i] = x / (1.f + __expf(-x));
      }
      __syncthreads();
      int kg = tid >> 6, nn = tid & 63;
      const float* Wm = p.in[4] + (size_t)layer * 1024 * NMOD + n0 + nn;
      float a0 = 0, a1 = 0, a2 = 0, a3 = 0, a4 = 0;
      for (int k0 = kg; k0 < 1024; k0 += 128) {
        float wv[16];
#pragma unroll
        for (int u = 0; u < 16; ++u) wv[u] = Wm[(size_t)(k0 + 8 * u) * NMOD];
#pragma unroll
        for (int u = 0; u < 16; ++u) {
          const int k = k0 + 8 * u;
          a0 += sv[k] * wv[u]; a1 += sv[1024 + k] * wv[u]; a2 += sv[2048 + k] * wv[u]; a3 += sv[3072 + k] * wv[u]; a4 += sv[4096 + k] * wv[u];
        }
      }
      red[(kg * 5 + 0) * 64 + nn] = a0; red[(kg * 5 + 1) * 64 + nn] = a1; red[(kg * 5 + 2) * 64 + nn] = a2; red[(kg * 5 + 3) * 64 + nn] = a3; red[(kg * 5 + 4) * 64 + nn] = a4;
      __syncthreads();
      if (tid < 320) {
        int v = tid >> 6; float sum = 0.f;
#pragma unroll
        for (int g = 0; g < 8; ++g) sum += red[(g * 5 + v) * 64 + nn];
        ((float*)(ws + WS_MODV))[((size_t)layer * 5 + v) * NMOD + n0 + nn] = sum + p.in[5][(size_t)layer * NMOD + n0 + nn];
      }
      __syncthreads();
    }
    else if (item < O_MISC) {
      int j = item - O_HY; int tb = j * 32;
      float* z = tl;
      float* h1 = tl + 32 * 36;
      float* h2 = h1 + 32 * 64;
      float* h3 = h2 + 32 * 64;
      const float* w1 = p.in[24]; const float* b1 = p.in[25]; const float* w2 = p.in[26]; const float* b2 = p.in[27];
      const float* w3 = p.in[28]; const float* b3 = p.in[29]; const float* fr = p.in[30]; const float* w4 = p.in[31];
      for (int i = tid; i < 32 * 33; i += NTH) {
        int tt = i / 33, e = i - tt * 33; int t = tb + tt; float val;
        if (e == 0) val = (float)t / (float)(L - 1);
        else {
          int jb = (e - 1) & 15;
          double fb = 1e-4 + (double)jb * ((15.0 - 1e-4) / 15.0);
          double rev = fb * (double)t / (double)L; rev -= floor(rev);
          float sn, cn; sincospif((float)(2.0 * rev), &sn, &cn);
          val = (e <= 16) ? cn : -sn;
        }
        z[tt * 36 + e] = val;
      }
      __syncthreads();
      for (int i = tid; i < 32 * 64; i += NTH) {
        int tt = i >> 6, o = i & 63; float a = b1[o];
        for (int e = 0; e < 33; ++e) a += z[tt * 36 + e] * w1[e * 64 + o];
        h1[tt * 64 + o] = sinf(fr[o] * a);
      }
      __syncthreads();
      for (int i = tid; i < 32 * 64; i += NTH) {
        int tt = i >> 6, o = i & 63; float a = b2[o];
        for (int e = 0; e < 64; ++e) a += h1[tt * 64 + e] * w2[e * 64 + o];
        h2[tt * 64 + o] = sinf(fr[o] * a);
      }
      __syncthreads();
      for (int i = tid; i < 32 * 64; i += NTH) {
        int tt = i >> 6, o = i & 63; float a = b3[o];
        for (int e = 0; e < 64; ++e) a += h2[tt * 64 + e] * w3[e * 64 + o];
        h3[tt * 64 + o] = sinf(fr[o] * a);
      }
      __syncthreads();
      const float min_decay = -3.0701134573253945f, max_decay = -15.350567286626972f;
      for (int nb = 0; nb < 2; ++nb) {
        const int n0 = nb * 2 * NTH + tid, n1 = n0 + NTH;
        float acc0[32], acc1[32];
#pragma unroll
        for (int tt = 0; tt < 32; ++tt) { acc0[tt] = 0.f; acc1[tt] = 0.f; }
        for (int e4 = 0; e4 < 16; ++e4) {
          const float* wr = w4 + (size_t)(4 * e4) * 2048;
          float wa0 = wr[n0], wb0 = wr[2048 + n0], wc0 = wr[4096 + n0], wd0 = wr[6144 + n0];
          float wa1 = wr[n1], wb1 = wr[2048 + n1], wc1 = wr[4096 + n1], wd1 = wr[6144 + n1];
#pragma unroll
          for (int tt = 0; tt < 32; ++tt) {
            float4 hv = *(const float4*)(h3 + tt * 64 + 4 * e4);
            acc0[tt] += hv.x * wa0 + hv.y * wb0 + hv.z * wc0 + hv.w * wd0;
            acc1[tt] += hv.x * wa1 + hv.y * wb1 + hv.z * wc1 + hv.w * wd1;
          }
        }
#pragma unroll
        for (int half = 0; half < 2; ++half) {
          const int n = half ? n1 : n0;
          int cc = n & 1023;
          float delta = fabsf(min_decay + (float)cc * ((max_decay - min_decay) / 1023.f));
          float* dst = (float*)(ws + WS_HT) + (size_t)n * L + tb;
#pragma unroll
          for (int t4 = 0; t4 < 8; ++t4) {
            float4 ov;
            ov.x = (half ? acc1[4 * t4] : acc0[4 * t4]) * __expf(-delta * (float)(tb + 4 * t4) / (float)(L - 1));
            ov.y = (half ? acc1[4 * t4 + 1] : acc0[4 * t4 + 1]) * __expf(-delta * (float)(tb + 4 * t4 + 1) / (float)(L - 1));
            ov.z = (half ? acc1[4 * t4 + 2] : acc0[4 * t4 + 2]) * __expf(-delta * (float)(tb + 4 * t4 + 2) / (float)(L - 1));
            ov.w = (half ? acc1[4 * t4 + 3] : acc0[4 * t4 + 3]) * __expf(-delta * (float)(tb + 4 * t4 + 3) / (float)(L - 1));
            *(float4*)(dst + 4 * t4) = ov;
          }
        }
      }
      __syncthreads();
    }
    else {
      ((unsigned*)(ws + WS_ZROW))[tid] = 0u;
      if (tid == 0) ((float2*)(ws + WS_ROPE))[2048] = make_float2(1.f, 0.f);
      for (int i = tid; i < 128 * 16; i += NTH) {
        int pos = i >> 4, jj = i & 15;
        float inv = exp2f(-(float)jj * (13.287712379549449f / 16.f));
        float sn, cn; sincosf((float)pos * inv, &sn, &cn);
        ((float2*)(ws + WS_ROPE))[i] = make_float2(cn, sn);
      }
      if (tid < 64) {
        float a = p.in[16][tid] * p.in[17][tid], bq = p.in[18][tid] * p.in[19][tid];
        a = wave_sum(a); bq = wave_sum(bq);
        if (tid == 0) *(float*)(ws + WS_MISC) = expf(a) - expf(bq) + 0.2f;
      }
      __syncthreads();
    }
  }
}

__device__ __forceinline__ void grid_bar(unsigned* ctr) {
  asm volatile("s_waitcnt vmcnt(0) lgkmcnt(0)" ::: "memory");
  __syncthreads();
  if (threadIdx.x == 0) {
    __threadfence();
    __hip_atomic_fetch_add(ctr, 1u, __ATOMIC_RELAXED, __HIP_MEMORY_SCOPE_AGENT);
    while (__hip_atomic_load(ctr, __ATOMIC_RELAXED, __HIP_MEMORY_SCOPE_AGENT) < gridDim.x) __builtin_amdgcn_s_sleep(2);
    __threadfence();
  }
  __syncthreads();
}

__global__ void __launch_bounds__(NTH) fwd_kernel(Params p) {
  extern __shared__ __attribute__((aligned(16))) char smem[];
  cg::grid_group grid = cg::this_grid();
  char* ws = p.ws;
  u16* RX = (u16*)(ws + WS_RX);
#ifdef ONLYP
#define PH(n) if ((n) == ONLYP)
#else
#define PH(n) if (p.ph_lo <= (n) && (n) < p.ph_hi)
#endif
#define SYNC(n) if (p.ph_lo <= (n) && (n) + 1 < p.ph_hi) grid_bar((unsigned*)(ws + WS_BAR) + 64 * (n));
  if (p.ph_hi > 1000) grid.sync();
  PH(0) phase_prep(p, smem);
  SYNC(0)
  PH(1) phase_ln(p, p.in[0], nullptr, nullptr, nullptr, nullptr, nullptr, 0, 0, 1024, true, true);
  SYNC(1)
  PH(2) phase_gemm1(p, smem);
  SYNC(2)
  PH(3) phase_attn_fourier(p, smem);
  SYNC(3)
  PH(4) phase_gemm_res<1>(p, smem, nullptr, 1024, (const u16*)(ws + WS_W2T), p.in[0], nullptr, RX, 0, 2048);
  SYNC(4)
  PH(5) phase_ln(p, nullptr, RX, p.in[6], p.in[7], nullptr, RX, 0, 3072, 4096, true, false);
  SYNC(5)
  PH(6) phase_gemm_ffn_in(p, smem, 0);
  SYNC(6)
  PH(7) phase_gemm_res<0>(p, smem, (const u16*)(ws + WS_H), FF, (const u16*)(ws + WS_W4T), nullptr, RX, RX, 0, 5120);
  SYNC(7)
  PH(8) phase_ln(p, nullptr, RX, p.in[8], p.in[9], nullptr, RX, 1, 0, 1024, true, false);
  SYNC(8)
  PH(9) phase_gemm_hy_in(p, smem);
  SYNC(9)
  PH(10) phase_hyena_fft(p, smem);
  SYNC(10)
  PH(11) phase_gemm_res<2>(p, smem, (const u16*)(ws + WS_GT), 1024, (const u16*)(ws + WS_W6T), nullptr, RX, RX, 1, 2048);
  SYNC(11)
  PH(12) phase_ln(p, nullptr, RX, p.in[6] + D, p.in[7] + D, nullptr, RX, 1, 3072, 4096, true, false);
  SYNC(12)
  PH(13) phase_gemm_ffn_in(p, smem, 1);
  SYNC(13)
  PH(14) phase_gemm_res<0>(p, smem, (const u16*)(ws + WS_H), FF, (const u16*)(ws + WS_W4T) + (size_t)1024 * FF, nullptr, RX, RX, 1, 5120);
  SYNC(14)
  PH(15) phase_ln(p, nullptr, RX, p.in[8] + D, p.in[9] + D, p.out, nullptr, 1, 0, 0, false, false);
#undef PH
#undef SYNC
}

extern "C" void kernel_launch(void* const* d_in, const int* in_sizes, int n_in, void* d_out, int out_size, void* d_ws, size_t ws_size, hipStream_t stream) {
  static int grid_blocks = 0;
  if (grid_blocks == 0) {
    if (n_in != 34 || ws_size < WS_END) { fprintf(stderr, "kernel_launch: bad n_in %d or ws %zu < %zu\n", n_in, ws_size, (size_t)WS_END); grid_blocks = -1; return; }
    int dev = 0, cus = 0, per_cu = 0;
    hipGetDevice(&dev);
    hipDeviceGetAttribute(&cus, hipDeviceAttributeMultiprocessorCount, dev);
    if (hipFuncSetAttribute((const void*)fwd_kernel, hipFuncAttributeMaxDynamicSharedMemorySize, LDS_BYTES) != hipSuccess) { fprintf(stderr, "hipFuncSetAttribute failed\n"); grid_blocks = -1; return; }
    hipOccupancyMaxActiveBlocksPerMultiprocessor(&per_cu, (const void*)fwd_kernel, NTH, LDS_BYTES);
    if (per_cu < 1) { fprintf(stderr, "occupancy 0\n"); grid_blocks = -1; return; }
    grid_blocks = cus * 1;
  }
  if (grid_blocks < 0) return;
  Params p{};
  for (int i = 0; i < 34; ++i) p.in[i] = (const float*)d_in[i];
  p.out = (float*)d_out; p.ws = (char*)d_ws; p.ph_lo = 0; p.ph_hi = 16;
  if (hipMemsetAsync((char*)d_ws + WS_BAR, 0, 16 * 256, stream) != hipSuccess) { fprintf(stderr, "memset failed\n"); return; }
  void* args[] = {&p};
  hipError_t e = hipLaunchCooperativeKernel((const void*)fwd_kernel, dim3(grid_blocks), dim3(NTH), args, LDS_BYTES, stream);
  if (e != hipSuccess) fprintf(stderr, "cooperative launch failed: %s (grid %d)\n", hipGetErrorString(e), grid_blocks);
#if DUP_PHASE >= 0
  {
    Params q = p; q.ph_lo = DUP_PHASE; q.ph_hi = DUP_PHASE + 1; q.flags = DUP_FLAGS;
    hipLaunchKernelGGL(fwd_kernel, dim3(grid_blocks), dim3(NTH), LDS_BYTES, stream, q);
  }
#endif
}
```
